# Optimizing an MI355X kernel written in HIP

```python
import jax, jax.numpy as jnp
from jax import lax
import numpy as np

D_MODEL = 1024
BATCH = 4
SEQ = 8192
DEPTH = 1

D_INNER = 2 * D_MODEL
M_WIDTH = D_INNER // 2
M_HEADS = 4
M_DV = M_WIDTH // M_HEADS
M_DQK = M_DV // 2
M_QK = M_HEADS * M_DQK
M_CHUNK = 128
GATE_CAP = 15.0
S_WIDTH = D_INNER - M_WIDTH
S_HEADDIM = 64
S_HEADS = S_WIDTH // S_HEADDIM
S_GROUPS = 2
S_STATE = 128
S_CONV = 4
S_CHUNK = 128
S_CONV_CH = S_WIDTH + 2 * S_GROUPS * S_STATE
EPS = 1e-6

IN_SIZES = (M_QK, M_QK, M_WIDTH, M_HEADS, M_HEADS, M_WIDTH, M_WIDTH, S_WIDTH, S_CONV_CH, S_HEADS)
D_IN_PROJ = sum(IN_SIZES)
SPLIT_POINTS = tuple(int(p) for p in np.cumsum(IN_SIZES)[:-1])

kernel_name = "hymba_mlstm_ssd_parallel_heads"


def rms_norm(x, w):
    xf = x.astype(jnp.float32)
    y = xf * lax.rsqrt(jnp.mean(xf * xf, axis=-1, keepdims=True) + EPS)
    return (y * w.astype(jnp.float32)).astype(x.dtype)


def soft_cap(u):
    return GATE_CAP * jnp.tanh(u / GATE_CAP)


def mlstm_chunkwise(q, k, v, log_i, log_f):
    f32 = jnp.float32
    Bsz, T = q.shape[0], q.shape[1]
    L = M_CHUNK
    NC = T // L
    q = q.astype(f32).reshape(Bsz, NC, L, M_HEADS, M_DQK) * (M_DQK ** -0.5)
    k = k.astype(f32).reshape(Bsz, NC, L, M_HEADS, M_DQK)
    v = v.astype(f32).reshape(Bsz, NC, L, M_HEADS, M_DV)
    li = log_i.reshape(Bsz, NC, L, M_HEADS).transpose(0, 3, 1, 2)
    lf = log_f.reshape(Bsz, NC, L, M_HEADS).transpose(0, 3, 1, 2)
    b = jnp.cumsum(lf, axis=-1)
    b_last = b[..., -1]
    g = b_last[..., None] - b + li
    g_max = jnp.max(g, axis=-1)
    w = jnp.exp(g - g_max[..., None])
    C_loc = jnp.einsum('bhcs,bcshk,bcshv->cbhkv', w, k, v)
    n_loc = jnp.einsum('bhcs,bcshk->cbhk', w, k)

    def step(carry, inp):
        C, n, m = carry
        a, gm, Cl, nl = inp
        m_new = jnp.maximum(a + m, gm)
        s_old = jnp.exp(a + m - m_new)
        s_loc = jnp.exp(gm - m_new)
        C_new = s_old[..., None, None] * C + s_loc[..., None, None] * Cl
        n_new = s_old[..., None] * n + s_loc[..., None] * nl
        return (C_new, n_new, m_new), (C, n, m)

    init = (jnp.zeros((Bsz, M_HEADS, M_DQK, M_DV), f32),
            jnp.zeros((Bsz, M_HEADS, M_DQK), f32),
            jnp.zeros((Bsz, M_HEADS), f32))
    xs = (jnp.moveaxis(b_last, 2, 0), jnp.moveaxis(g_max, 2, 0), C_loc, n_loc)
    _, (C_prev, n_prev, m_prev) = lax.scan(step, init, xs)
    m_prev = jnp.moveaxis(m_prev, 0, 2)

    causal = jnp.tril(jnp.ones((L, L), dtype=bool))
    D = b[..., :, None] - b[..., None, :] + li[..., None, :]
    D = jnp.where(causal, D, -jnp.inf)
    m_inter = b + m_prev[..., None]
    m_j = jnp.maximum(m_inter, jnp.max(D, axis=-1))
    S = jnp.einsum('bcjhk,bcshk->bhcjs', q, k) * jnp.exp(D - m_j[..., None])
    num = jnp.einsum('bhcjs,bcshv->bcjhv', S, v)
    den = jnp.sum(S, axis=-1)
    inter_scale = jnp.exp(m_inter - m_j)
    num = num + jnp.einsum('bcjhk,cbhkv->bcjhv', q, C_prev) * inter_scale.transpose(0, 2, 3, 1)[..., None]
    den = den + jnp.einsum('bcjhk,cbhk->bhcj', q, n_prev) * inter_scale
    denom = jnp.maximum(jnp.abs(den), jnp.exp(-m_j))
    h = num / denom.transpose(0, 2, 3, 1)[..., None]
    return h.reshape(Bsz, T, M_HEADS, M_DV)


def causal_depthwise_conv(u, w, b):
    kern = jnp.transpose(w)[:, None, :].astype(u.dtype)
    out = lax.conv_general_dilated(u, kern, window_strides=(1,), padding=[(S_CONV - 1, 0)],
                                   dimension_numbers=('NWC', 'WIO', 'NWC'),
                                   feature_group_count=u.shape[-1])
    return out + b.astype(u.dtype)


def ssd_chunked(x, dt, A, Bm, Cm):
    f32 = jnp.float32
    Bsz, T = x.shape[0], x.shape[1]
    L = S_CHUNK
    NC = T // L
    R = S_HEADS // S_GROUPS
    x = x.astype(f32).reshape(Bsz, NC, L, S_GROUPS, R, S_HEADDIM)
    dt = dt.reshape(Bsz, NC, L, S_GROUPS, R)
    Bm = Bm.astype(f32).reshape(Bsz, NC, L, S_GROUPS, S_STATE)
    Cm = Cm.astype(f32).reshape(Bsz, NC, L, S_GROUPS, S_STATE)
    a = (dt * A.reshape(S_GROUPS, R)).transpose(0, 3, 4, 1, 2)
    a_cum = jnp.cumsum(a, axis=-1)
    xdt = x * dt[..., None]
    causal = jnp.tril(jnp.ones((L, L), dtype=bool))
    decay = jnp.exp(jnp.where(causal, a_cum[..., :, None] - a_cum[..., None, :], -jnp.inf))
    CB = jnp.einsum('bclgn,bcsgn->bgcls', Cm, Bm)
    y_diag = jnp.einsum('bgcls,bgrcls,bcsgrp->bclgrp', CB, decay, xdt)
    decay_end = jnp.exp(a_cum[..., -1:] - a_cum)
    states = jnp.einsum('bcsgn,bgrcs,bcsgrp->cbgrpn', Bm, decay_end, xdt)
    chunk_decay = jnp.moveaxis(jnp.exp(a_cum[..., -1]), -1, 0)

    def step(h, inp):
        dA, s = inp
        return dA[..., None, None] * h + s, h

    h0 = jnp.zeros((Bsz, S_GROUPS, R, S_HEADDIM, S_STATE), f32)
    _, h_prev = lax.scan(step, h0, (chunk_decay, states))
    y_off = jnp.einsum('bclgn,cbgrpn,bgrcl->bclgrp', Cm, h_prev, jnp.exp(a_cum))
    return (y_diag + y_off).reshape(Bsz, T, S_HEADS, S_HEADDIM)


def setup_inputs(seed: int = 0) -> dict:
    key = jax.random.key(seed)
    ks = jax.random.split(key, 16)
    f32 = jnp.float32
    x = jax.random.normal(ks[0], (BATCH, SEQ, D_MODEL), f32)
    norm_w = 1.0 + 0.01 * jax.random.normal(ks[1], (DEPTH, D_MODEL), f32)
    w_in = jax.random.normal(ks[2], (DEPTH, D_MODEL, D_IN_PROJ), f32) * D_MODEL ** -0.5
    b_igate = 0.1 * jax.random.normal(ks[3], (DEPTH, M_HEADS), f32)
    b_fgate = jnp.linspace(3.0, 6.0, M_HEADS, dtype=f32)[None, :] + 0.1 * jax.random.normal(ks[4], (DEPTH, M_HEADS), f32)
    conv_w = jax.random.normal(ks[5], (DEPTH, S_CONV_CH, S_CONV), f32) * S_CONV ** -0.5
    conv_b = 0.01 * jax.random.normal(ks[6], (DEPTH, S_CONV_CH), f32)
    dt0 = jnp.exp(jax.random.uniform(ks[7], (DEPTH, S_HEADS), f32, minval=float(np.log(1e-3)), maxval=float(np.log(1e-1))))
    dt_bias = dt0 + jnp.log(-jnp.expm1(-dt0))
    a_log = jnp.log(jax.random.uniform(ks[8], (DEPTH, S_HEADS), f32, minval=1.0, maxval=16.0))
    d_skip = 1.0 + 0.1 * jax.random.normal(ks[9], (DEPTH, S_HEADS), f32)
    mlstm_norm_w = 1.0 + 0.01 * jax.random.normal(ks[10], (DEPTH, M_WIDTH), f32)
    ssd_norm_w = 1.0 + 0.01 * jax.random.normal(ks[11], (DEPTH, S_WIDTH), f32)
    w_out = jax.random.normal(ks[12], (DEPTH, D_INNER, D_MODEL), f32) * D_INNER ** -0.5
    final_norm_w = 1.0 + 0.01 * jax.random.normal(ks[13], (D_MODEL,), f32)
    return {"x": x, "norm_w": norm_w, "w_in": w_in, "b_igate": b_igate, "b_fgate": b_fgate,
            "conv_w": conv_w, "conv_b": conv_b, "dt_bias": dt_bias, "a_log": a_log,
            "d_skip": d_skip, "mlstm_norm_w": mlstm_norm_w, "ssd_norm_w": ssd_norm_w,
            "w_out": w_out, "final_norm_w": final_norm_w}


def reference(x, norm_w, w_in, b_igate, b_fgate, conv_w, conv_b, dt_bias, a_log, d_skip,
              mlstm_norm_w, ssd_norm_w, w_out, final_norm_w):
    f32 = jnp.float32
    dtype = x.dtype
    Bsz, T = x.shape[0], x.shape[1]
    for l in range(DEPTH):
        h = rms_norm(x, norm_w[l])
        proj = h @ w_in[l]
        q, k, v, i_pre, f_pre, o_pre, z_m, z_s, xbc, dt_raw = jnp.split(proj, SPLIT_POINTS, axis=-1)

        log_i = soft_cap(i_pre.astype(f32) + b_igate[l].astype(f32))
        log_f = jax.nn.log_sigmoid(soft_cap(f_pre.astype(f32) + b_fgate[l].astype(f32)))
        hm = mlstm_chunkwise(q.reshape(Bsz, T, M_HEADS, M_DQK),
                             k.reshape(Bsz, T, M_HEADS, M_DQK),
                             v.reshape(Bsz, T, M_HEADS, M_DV), log_i, log_f)
        hm = hm * lax.rsqrt(jnp.mean(hm * hm, axis=-1, keepdims=True) + EPS)
        hm = hm.reshape(Bsz, T, M_WIDTH) * mlstm_norm_w[l].astype(f32)
        hm = hm * jax.nn.sigmoid(o_pre.astype(f32)) * jax.nn.silu(z_m.astype(f32))

        xbc = jax.nn.silu(causal_depthwise_conv(xbc, conv_w[l], conv_b[l]))
        xs, Bm, Cm = jnp.split(xbc, (S_WIDTH, S_WIDTH + S_GROUPS * S_STATE), axis=-1)
        xs = xs.reshape(Bsz, T, S_HEADS, S_HEADDIM)
        dt = jax.nn.softplus(dt_raw.astype(f32) + dt_bias[l].astype(f32))
        A = -jnp.exp(a_log[l].astype(f32))
        y = ssd_chunked(xs, dt, A,
                        Bm.reshape(Bsz, T, S_GROUPS, S_STATE),
                        Cm.reshape(Bsz, T, S_GROUPS, S_STATE))
        y = y + d_skip[l].astype(f32)[:, None] * xs.astype(f32)
        y = y.reshape(Bsz, T, S_WIDTH) * jax.nn.silu(z_s.astype(f32))
        yg = y.reshape(Bsz, T, S_GROUPS, S_WIDTH // S_GROUPS)
        yg = yg * lax.rsqrt(jnp.mean(yg * yg, axis=-1, keepdims=True) + EPS)
        y = yg.reshape(Bsz, T, S_WIDTH) * ssd_norm_w[l].astype(f32)

        mix = jnp.concatenate([hm, y], axis=-1).astype(dtype)
        x = x + mix @ w_out[l]
    return rms_norm(x, final_norm_w)
```

```cpp
#include <hip/hip_runtime.h>
#include <hip/hip_cooperative_groups.h>
#include <cstdio>
namespace cg = cooperative_groups;

#define LAS __attribute__((address_space(3)))
typedef unsigned short u16;
typedef short bf16x8 __attribute__((ext_vector_type(8)));
typedef float f32x4 __attribute__((ext_vector_type(4)));
typedef float f32x2 __attribute__((ext_vector_type(2)));
typedef unsigned u32x4 __attribute__((ext_vector_type(4)));
typedef unsigned u32x2 __attribute__((ext_vector_type(2)));
typedef __bf16 bf16x2_t __attribute__((ext_vector_type(2)));

#ifndef ONE_LAUNCH
#define ONE_LAUNCH 1
#endif

constexpr int T = 32768, DM = 1024, SEQ = 8192, NCH = 64, CL = 128;
constexpr int DIN = 6680;
constexpr int LDP = 6656;
constexpr int PQ = 0, PK = 512, PV = 1024, PZM = 2048, PO = 3072, PZS = 4096, PX = 5120, PBM = 6144, PCM = 6400;
constexpr int NGT = 32;
constexpr float EPS = 1e-6f, CAP = 15.0f;
constexpr int NTHR = 512;
constexpr int LDS_BYTES = 163840;

constexpr size_t WS_WTIN = 0;
constexpr size_t WS_WTOUT = WS_WTIN + (size_t)LDP * DM * 2;
constexpr size_t WS_G = WS_WTOUT + (size_t)1024 * 2048 * 2;
constexpr size_t WS_NLOC = WS_G + (size_t)T * NGT * 4;
constexpr size_t WS_MBL = WS_NLOC + (size_t)1024 * 128 * 4;
constexpr size_t WS_MGM = WS_MBL + 4096;
constexpr size_t WS_MPREV = WS_MGM + 4096;
constexpr size_t WS_SDEC = WS_MPREV + 4096;
constexpr size_t WS_BAR = WS_SDEC + 16384;
constexpr size_t WS_RSG = WS_BAR + 16384;
constexpr size_t WS_LU = WS_RSG + (size_t)T * 2 * 4;
constexpr size_t WS_LB = WS_LU + (size_t)1024 * 128 * 4;
constexpr size_t WS_SG = WS_LB + (size_t)1024 * 128 * 4;
constexpr size_t WS_H = WS_SG + (size_t)512 * 2048 * 4;
constexpr size_t WS_P = WS_H + (size_t)T * DM * 2;
constexpr size_t WS_END = WS_P + (size_t)T * LDP * 2;

struct Params {
    const float *x, *norm_w, *w_in, *b_i, *b_f, *conv_w, *conv_b, *dt_bias, *a_log, *d_skip, *mnw, *snw, *w_out, *fnw;
    float* out; unsigned char* ws; int ph_lo, ph_hi;
};

__device__ __forceinline__ unsigned pk2(float lo, float hi) { f32x2 v = {lo, hi}; bf16x2_t b = __builtin_convertvector(v, bf16x2_t); return __builtin_bit_cast(unsigned, b); }
__device__ __forceinline__ u16 f2bf(float f) { return (u16)(pk2(f, 0.f) & 0xffffu); }
__device__ __forceinline__ float bf2f(u16 b) { return __uint_as_float((unsigned)b << 16); }
__device__ __forceinline__ float bflo(unsigned u) { return __uint_as_float(u << 16); }
__device__ __forceinline__ float bfhi(unsigned u) { return __uint_as_float(u & 0xffff0000u); }
__device__ __forceinline__ void unpack8(const u32x4 v, float* f) {
    f[0] = bflo(v.x); f[1] = bfhi(v.x); f[2] = bflo(v.y); f[3] = bfhi(v.y); f[4] = bflo(v.z); f[5] = bfhi(v.z); f[6] = bflo(v.w); f[7] = bfhi(v.w);
}
__device__ __forceinline__ float wave_sum(float v) {
#pragma unroll
    for (int o = 1; o < 64; o <<= 1) v += __shfl_xor(v, o);
    return v;
}
__device__ __forceinline__ float siluf(float v) { return v * __builtin_amdgcn_rcpf(1.f + __expf(-v)); }
__device__ __forceinline__ float sigmf(float v) { return __builtin_amdgcn_rcpf(1.f + __expf(-v)); }
__device__ __forceinline__ float softplusf(float v) { return fmaxf(v, 0.f) + log1pf(expf(-fabsf(v))); }
__device__ __forceinline__ float softcap(float v) { return CAP * tanhf(v * (1.0f / CAP)); }
#define LDS_WAIT() asm volatile("s_waitcnt lgkmcnt(0)" ::: "memory")

template <int MT, int NT, int KS>
__device__ __forceinline__ void mma_lds(f32x4 (&acc)[MT][NT], const LAS u16* A, int lda, const LAS u16* B, int ldb, int lane) {
    const int r = lane & 15, q = lane >> 4;
#pragma unroll
    for (int ks = 0; ks < KS; ++ks) {
        asm volatile("" ::: "memory");
        bf16x8 a[MT], b[NT];
#pragma unroll
        for (int m = 0; m < MT; ++m) a[m] = *(const LAS bf16x8*)(A + (m * 16 + r) * lda + ks * 32 + q * 8);
#pragma unroll
        for (int n = 0; n < NT; ++n) b[n] = *(const LAS bf16x8*)(B + (n * 16 + r) * ldb + ks * 32 + q * 8);
#pragma unroll
        for (int m = 0; m < MT; ++m)
#pragma unroll
            for (int n = 0; n < NT; ++n) acc[m][n] = __builtin_amdgcn_mfma_f32_16x16x32_bf16(a[m], b[n], acc[m][n], 0, 0, 0);
    }
}


typedef short v4i16_t __attribute__((ext_vector_type(4)));
__device__ __forceinline__ bf16x8 frag_tr(const LAS u16* X, int ld, int k0, int n0, int lane) {
    const int g = lane >> 4, a = lane & 15;
    const LAS u16* p0 = X + (k0 + 8 * g + (a >> 2)) * ld + n0 + (a & 3) * 4;
    const v4i16_t lo = __builtin_amdgcn_ds_read_tr16_b64_v4i16((LAS v4i16_t*)p0);
    const v4i16_t hi = __builtin_amdgcn_ds_read_tr16_b64_v4i16((LAS v4i16_t*)(p0 + 4 * ld));
    return __builtin_shufflevector(lo, hi, 0, 1, 2, 3, 4, 5, 6, 7);
}
template <int MT, int NT, int KS>
__device__ __forceinline__ void mma_lds_bt(f32x4 (&acc)[MT][NT], const LAS u16* A, int lda, const LAS u16* B, int ldb, int lane) {
    const int r = lane & 15, q = lane >> 4;
#pragma unroll
    for (int ks = 0; ks < KS; ++ks) {
        asm volatile("" ::: "memory");
        bf16x8 a[MT], b[NT];
#pragma unroll
        for (int m = 0; m < MT; ++m) a[m] = *(const LAS bf16x8*)(A + (m * 16 + r) * lda + ks * 32 + q * 8);
#pragma unroll
        for (int n = 0; n < NT; ++n) b[n] = frag_tr(B, ldb, ks * 32, n * 16, lane);
#pragma unroll
        for (int m = 0; m < MT; ++m)
#pragma unroll
            for (int n = 0; n < NT; ++n) acc[m][n] = __builtin_amdgcn_mfma_f32_16x16x32_bf16(a[m], b[n], acc[m][n], 0, 0, 0);
    }
}
template <int MT, int NT, int KS>
__device__ __forceinline__ void mma_lds_tt(f32x4 (&acc)[MT][NT], const LAS u16* A, int lda, const LAS u16* B, int ldb, int lane) {
#pragma unroll
    for (int ks = 0; ks < KS; ++ks) {
        asm volatile("" ::: "memory");
        bf16x8 a[MT], b[NT];
#pragma unroll
        for (int m = 0; m < MT; ++m) a[m] = frag_tr(A, lda, ks * 32, m * 16, lane);
#pragma unroll
        for (int n = 0; n < NT; ++n) b[n] = frag_tr(B, ldb, ks * 32, n * 16, lane);
#pragma unroll
        for (int m = 0; m < MT; ++m)
#pragma unroll
            for (int n = 0; n < NT; ++n) acc[m][n] = __builtin_amdgcn_mfma_f32_16x16x32_bf16(a[m], b[n], acc[m][n], 0, 0, 0);
    }
}

namespace pg8 {
constexpr int BM = 256, BK = 64, HALF = 128, HTB = HALF * BK * 2, STAGE_BYTES = 8 * HTB, NXCD = 8, WGM = 8;
__device__ __forceinline__ int lds_byte(int r, int c) { const int st = (r >> 4) * 2 + (c >> 5), rr = r & 15, cc = c & 31, ob = rr * 64 + cc * 2; return st * 1024 + (ob ^ (((ob >> 9) & 1) << 5)); }
__device__ __forceinline__ void stage_rc(int b, int& R, int& C) { const int st = b / 1024, sb = b % 1024, swz = sb ^ (((sb >> 9) & 1) << 5); R = (st >> 1) * 16 + swz / 64; C = (st & 1) * 32 + (swz % 64) / 2; }
__device__ __forceinline__ int perm32(int rho) { const int n = rho >> 4, i = rho & 15; return 8 * (i >> 2) + 4 * n + (i & 3); }
struct Unit { int pm, pn; };
struct Gemm { const u16* A; const u16* Bt; int M, N, K, lda; };
struct StaticOrder {
    int nM, nN, nwg, G, c;
    __device__ void init(int M, int N, int G_, int c_) { nM = M / BM; nN = N / BM; nwg = nM * nN; G = G_; c = c_; }
    __device__ bool next(int i, Unit& u) const {
        const long Lx = (long)i * G + c; if (Lx >= nwg) return false;
        int wgid = (int)Lx; { const int q = nwg / NXCD, r = nwg % NXCD, xcd = wgid % NXCD, off = wgid / NXCD; wgid = (xcd < r ? xcd * (q + 1) : r * (q + 1) + (xcd - r) * q) + off; }
        const int nig = WGM * nN, gid = wgid / nig, fm = gid * WGM, gsz = (nM - fm) < WGM ? (nM - fm) : WGM;
        u.pm = fm + ((wgid % nig) % gsz); u.pn = (wgid % nig) / gsz; return true;
    }
};
struct EpiP {
    static constexpr bool PERM = true, HORNER = false;
    u16* O; int ldc; const float* rsg;
    __device__ __forceinline__ void operator()(const f32x4 (&acc)[2][2][4][2], const Unit& u, int wr, int wc, int fr, int fq) const {
        const int row0 = u.pm * BM + wr * 64 + fr; const int col0 = u.pn * BM + wc * 32 + 8 * fq;
        if (u.pn >= 8 && u.pn < 16) {
            const int gcol = 2048 + 128 * (u.pn - 8) + wc * 32 + 8 * fq;
#pragma unroll
            for (int ai = 0; ai < 2; ++ai)
#pragma unroll
                for (int m = 0; m < 4; ++m) { u16* rowp = O + (size_t)(row0 + ai * HALF + m * 16) * ldc + gcol;
                    float gt[8];
#pragma unroll
                    for (int n = 0; n < 2; ++n)
#pragma unroll
                        for (int i = 0; i < 4; ++i) { const float zo = acc[ai][1][m][n][i]; gt[n * 4 + i] = zo * __builtin_amdgcn_rcpf((1.f + __expf(-acc[ai][0][m][n][i])) * (1.f + __expf(-zo))); }
                    u32x4 w; w.x = pk2(gt[0], gt[1]); w.y = pk2(gt[2], gt[3]); w.z = pk2(gt[4], gt[5]); w.w = pk2(gt[6], gt[7]);
                    __builtin_nontemporal_store(w, (u32x4*)rowp); }
            return;
        }
        const bool zs_tile = u.pn >= 16 && u.pn < 20;
#pragma unroll
        for (int ai = 0; ai < 2; ++ai)
#pragma unroll
            for (int m = 0; m < 4; ++m) { u16* rowp = O + (size_t)(row0 + ai * HALF + m * 16) * ldc + col0;
#pragma unroll
                for (int bj = 0; bj < 2; ++bj) { f32x4 v0 = acc[ai][bj][m][0], v1 = acc[ai][bj][m][1];
                    if (zs_tile) {
#pragma unroll
                        for (int i = 0; i < 4; ++i) { v0[i] = siluf(v0[i]); v1[i] = siluf(v1[i]); } }
                    u32x4 w; w.x = pk2(v0[0], v0[1]); w.y = pk2(v0[2], v0[3]); w.z = pk2(v1[0], v1[1]); w.w = pk2(v1[2], v1[3]);
                    __builtin_nontemporal_store(w, (u32x4*)(rowp + bj * HALF)); } }
    }
};
struct EpiOut {
    static constexpr bool PERM = true, HORNER = true;
    u16* Z; const float* res; int ldc; const float* rsg;
    __device__ __forceinline__ void operator()(const f32x4 (&acc)[2][2][4][2], const Unit& u, int wr, int wc, int fr, int fq, const LAS unsigned char* fac) const {
        const int row0 = u.pm * BM + wr * 64 + fr, col0 = u.pn * BM + wc * 32 + 8 * fq;
#pragma unroll
        for (int ai = 0; ai < 2; ++ai)
#pragma unroll
            for (int m = 0; m < 4; ++m) { u16* rowp = Z + (size_t)(row0 + ai * HALF + m * 16) * ldc + col0;
                const float r1 = ((const LAS float*)fac)[2 * (ai * HALF + wr * 64 + m * 16 + fr) + 1];
#pragma unroll
                for (int bj = 0; bj < 2; ++bj) { const f32x4 v0 = acc[ai][bj][m][0] * r1, v1 = acc[ai][bj][m][1] * r1;
                    u32x4 w; w.x = pk2(v0[0], v0[1]); w.y = pk2(v0[2], v0[3]); w.z = pk2(v1[0], v1[1]); w.w = pk2(v1[2], v1[3]);
                    *(u32x4*)(rowp + bj * HALF) = w; } }
    }
};

template <class Epi, class Sched>
__device__ __forceinline__ void gemm_phase(LAS unsigned char* lds, const Gemm g, const Sched& S, const Epi& E) {
    const int tid = threadIdx.x, wid = __builtin_amdgcn_readfirstlane(tid >> 6), lane = tid & 63, wr = wid >> 2, wc = wid & 3, fr = lane & 15, fq = lane >> 4;
    const int K = g.K, nt = K / BK, lda = g.lda;
    unsigned voffA[2], voffB[2];
#pragma unroll
    for (int i = 0; i < 2; ++i) { int R, C; stage_rc(tid * 16 + i * 8192, R, C); const int Rb = Epi::PERM ? ((R & ~31) + perm32(R & 31)) : R;
        voffA[i] = (unsigned)(R * lda + C) * 2u; voffB[i] = (unsigned)(Rb * K + C) * 2u; }
    const size_t kstep = (size_t)(BK * 2);
    const size_t hstepA = (size_t)HALF * lda * 2, hstepB = (size_t)HALF * K * 2;
    const size_t tstepA = 2 * hstepA, tstepB = 2 * hstepB;
    const unsigned ldsw = (unsigned)wid * 1024u;
    const int aoff = lds_byte(wr * 64 + fr, fq * 8), boff = lds_byte(wc * 32 + fr, fq * 8);
#define PG8_SA(b, h) (((b) * 2 + (h)) * HTB)
#define PG8_SB(b, h) ((4 + (b) * 2 + (h)) * HTB)
#define PG8_STAGE(bufoff, gbase, voff) do { _Pragma("unroll") for (int _i = 0; _i < 2; ++_i) \
        __builtin_amdgcn_global_load_lds((const unsigned*)((const char*)(gbase) + (voff)[_i]), (LAS unsigned*)(lds + (bufoff) + ldsw + _i * 8192), 16, 0, 0); } while (0)
#define PG8_LDA(dst, b, h) do { _Pragma("unroll") for (int m = 0; m < 4; ++m) _Pragma("unroll") for (int k = 0; k < 2; ++k) dst[m][k] = *(const LAS bf16x8*)(lds + PG8_SA(b, h) + aoff + m * 2048 + k * 1024); } while (0)
#define PG8_LDB(dst, b, h) do { _Pragma("unroll") for (int n = 0; n < 2; ++n) _Pragma("unroll") for (int k = 0; k < 2; ++k) dst[n][k] = *(const LAS bf16x8*)(lds + PG8_SB(b, h) + boff + n * 2048 + k * 1024); } while (0)
#define PG8_MMA(ai, bj, At, Bt) do { __builtin_amdgcn_s_setprio(1); _Pragma("unroll") for (int m = 0; m < 4; ++m) _Pragma("unroll") for (int n = 0; n < 2; ++n) _Pragma("unroll") for (int k = 0; k < 2; ++k) \
        acc[ai][bj][m][n] = __builtin_amdgcn_mfma_f32_16x16x32_bf16(Bt[n][k], At[m][k], acc[ai][bj][m][n], 0, 0, 0); __builtin_amdgcn_s_setprio(0); } while (0)
#define PG8_WAIT_V(n) asm volatile("s_waitcnt vmcnt(" #n ")" ::: "memory")
#define PG8_WAIT_L(n) asm volatile("s_waitcnt lgkmcnt(" #n ")" ::: "memory")
#define PG8_BAR __builtin_amdgcn_s_barrier()
#define PG8_SCHED __builtin_amdgcn_sched_barrier(0)
    Unit cur, nxt; int ui = 0;
    if (!S.next(0, cur)) return;
    f32x4 acc[2][2][4][2];
#pragma unroll
    for (int a = 0; a < 2; ++a)
#pragma unroll
        for (int b = 0; b < 2; ++b)
#pragma unroll
            for (int m = 0; m < 4; ++m)
#pragma unroll
                for (int n = 0; n < 2; ++n) acc[a][b][m][n] = (f32x4){0.f, 0.f, 0.f, 0.f};
    bf16x8 At[4][2], B0[2][2], B1[2][2];
    const char* cA = (const char*)g.A + (size_t)cur.pm * tstepA; const char* cB = (const char*)g.Bt + (size_t)cur.pn * tstepB;
#define PG8_AK(t_) ((size_t)(t_) * kstep)
#define PG8_HLOAD(u_) do { if constexpr (Epi::HORNER) { __builtin_amdgcn_global_load_lds((const unsigned*)(E.rsg + 2 * (size_t)(u_).pm * BM + tid), (LAS unsigned*)(lds + STAGE_BYTES + (ui & 1) * 2048 + wid * 256), 4, 0, 0); } } while (0)
#define PG8_HSCALE(second_) do { _Pragma("unroll") for (int ai = 0; ai < 2; ++ai) _Pragma("unroll") for (int m = 0; m < 4; ++m) { asm volatile("" ::: "memory"); \
        const f32x2 rr_ = *(const LAS f32x2*)(lds + STAGE_BYTES + (ui & 1) * 2048 + 8 * (ai * HALF + wr * 64 + m * 16 + fr)); const float hf_ = (second_) ? rr_.x * __builtin_amdgcn_rcpf(rr_.y) : __builtin_amdgcn_rcpf(rr_.x); \
        _Pragma("unroll") for (int bj = 0; bj < 2; ++bj) _Pragma("unroll") for (int n = 0; n < 2; ++n) acc[ai][bj][m][n] *= hf_; } } while (0)
    PG8_HLOAD(cur);
    PG8_STAGE(PG8_SB(0, 0), cB, voffB); PG8_STAGE(PG8_SA(0, 0), cA + PG8_AK(0), voffA); PG8_STAGE(PG8_SB(0, 1), cB + hstepB, voffB); PG8_STAGE(PG8_SA(0, 1), cA + PG8_AK(0) + hstepA, voffA);
    if (wr == 1) PG8_BAR;
    PG8_WAIT_V(4); PG8_BAR;
    PG8_STAGE(PG8_SB(1, 0), cB + kstep, voffB); PG8_STAGE(PG8_SA(1, 0), cA + PG8_AK(1), voffA); PG8_STAGE(PG8_SB(1, 1), cB + hstepB + kstep, voffB);
    PG8_WAIT_V(6); PG8_BAR;
    for (;;) {
        const bool has_next = S.next(ui + 1, nxt);
        const char* nA = has_next ? (const char*)g.A + (size_t)nxt.pm * tstepA : cA; const char* nB = has_next ? (const char*)g.Bt + (size_t)nxt.pn * tstepB : cB;
#pragma unroll 1
        for (int seg = 0; seg < (Epi::HORNER ? 3 : 1); ++seg) {
        const int tb = Epi::HORNER ? (seg == 0 ? 0 : (seg == 1 ? 16 : 24)) : 0, te = Epi::HORNER ? (seg == 0 ? 16 : (seg == 1 ? 24 : nt)) : nt;
        if constexpr (Epi::HORNER) { if (seg > 0) PG8_HSCALE(seg == 2); }
#pragma unroll 1
        for (int t = tb; t < te; t += 2) {
            const bool last = (t == nt - 2);
            const char* a1 = cA + PG8_AK(t + 1);
            const char* a2 = last ? nA + PG8_AK(0) : cA + PG8_AK(t + 2); const char* b2 = last ? nB : cB + (size_t)(t + 2) * kstep;
            const char* a3 = last ? nA + PG8_AK(1) : cA + PG8_AK(t + 3); const char* b3 = b2 + kstep;
            PG8_LDB(B0, 0, 0); PG8_SCHED; PG8_LDA(At, 0, 0); PG8_STAGE(PG8_SA(1, 1), a1 + hstepA, voffA);
            PG8_WAIT_L(8); PG8_BAR; PG8_WAIT_L(0); PG8_MMA(0, 0, At, B0); PG8_BAR; PG8_SCHED;
            PG8_LDB(B1, 0, 1); PG8_STAGE(PG8_SB(0, 0), b2, voffB);
            PG8_BAR; PG8_WAIT_L(0); PG8_MMA(0, 1, At, B1); PG8_BAR;
            PG8_LDA(At, 0, 1); PG8_STAGE(PG8_SA(0, 0), a2, voffA);
            PG8_BAR; PG8_WAIT_L(0); PG8_MMA(1, 0, At, B0); PG8_BAR; PG8_SCHED;
            PG8_STAGE(PG8_SB(0, 1), b2 + hstepB, voffB);
            PG8_WAIT_V(6); PG8_BAR; PG8_MMA(1, 1, At, B1); PG8_BAR;
            PG8_LDB(B0, 1, 0); PG8_SCHED; PG8_LDA(At, 1, 0); PG8_STAGE(PG8_SA(0, 1), a2 + hstepA, voffA);
            PG8_WAIT_L(8); PG8_BAR; PG8_WAIT_L(0); PG8_MMA(0, 0, At, B0); PG8_BAR; PG8_SCHED;
            PG8_LDB(B1, 1, 1); PG8_STAGE(PG8_SB(1, 0), b3, voffB);
            PG8_BAR; PG8_WAIT_L(0); PG8_MMA(0, 1, At, B1); PG8_BAR;
            PG8_LDA(At, 1, 1); PG8_STAGE(PG8_SA(1, 0), a3, voffA);
            PG8_BAR; PG8_WAIT_L(0); PG8_MMA(1, 0, At, B0); PG8_BAR; PG8_SCHED;
            PG8_STAGE(PG8_SB(1, 1), b3 + hstepB, voffB);
            PG8_WAIT_V(6); PG8_BAR; PG8_MMA(1, 1, At, B1); PG8_BAR;
        }
        }
        if constexpr (Epi::HORNER) E(acc, cur, wr, wc, fr, fq, lds + STAGE_BYTES + (ui & 1) * 2048); else E(acc, cur, wr, wc, fr, fq);
        if (!has_next) break;
#pragma unroll
        for (int a = 0; a < 2; ++a)
#pragma unroll
            for (int b = 0; b < 2; ++b)
#pragma unroll
                for (int m = 0; m < 4; ++m)
#pragma unroll
                    for (int n = 0; n < 2; ++n) acc[a][b][m][n] = (f32x4){0.f, 0.f, 0.f, 0.f};
        cur = nxt; cA = nA; cB = nB; ++ui;
        PG8_HLOAD(cur);
    }
    PG8_WAIT_V(0);
    if (wr == 0) PG8_BAR;
    PG8_BAR;
#undef PG8_AK
#undef PG8_HLOAD
#undef PG8_HSCALE
#undef PG8_SA
#undef PG8_SB
#undef PG8_STAGE
#undef PG8_LDA
#undef PG8_LDB
#undef PG8_MMA
#undef PG8_WAIT_V
#undef PG8_WAIT_L
#undef PG8_BAR
#undef PG8_SCHED
}
}

#include <hip/hip_runtime.h>
#include <cstdio>

#define XB_TMO      128
#define XB_XCNT(j)  (256  + 64 * (j))
#define XB_XSUB(j)  (1280 + 64 * (j))
#define XB_XGEN(j)  (2304 + 64 * (j))
#define XB_TOP      3328
#define XB_TOPGEN   3392
#define XCD_BAR_WORDS 3456
#define XB_SPIN_CAP (1u << 18)

__device__ __forceinline__ unsigned xb_ld(unsigned* p)              { return __hip_atomic_load(p, __ATOMIC_RELAXED, __HIP_MEMORY_SCOPE_AGENT); }
__device__ __forceinline__ unsigned xb_add(unsigned* p, unsigned v) { return __hip_atomic_fetch_add(p, v, __ATOMIC_RELAXED, __HIP_MEMORY_SCOPE_AGENT); }
__device__ __forceinline__ unsigned xb_xcc_id() { return (unsigned)__builtin_amdgcn_s_getreg((3 << 11) | 20) & 0xFu; }
#define XB_SPIN(cond, bar) do { unsigned _sp = 0; while (cond) { __builtin_amdgcn_s_sleep(1); \
    if ((++_sp & 255u) == 0u) { if (xb_ld(&(bar)[XB_TMO])) break; if (_sp > XB_SPIN_CAP) { atomicAdd(&(bar)[XB_TMO], 1u); break; } } } } while (0)

struct XcdBarrier {
    unsigned* bar; unsigned x;
    volatile LAS unsigned* st;
};

__device__ __forceinline__ XcdBarrier xcd_barrier_post(unsigned* bar, volatile LAS unsigned* st) {
    XcdBarrier b; b.bar = bar; b.x = xb_xcc_id(); b.st = st;
    if (threadIdx.x == 0) (void)xb_add(&bar[XB_XCNT(b.x)], 1u);
    return b;
}
__device__ __forceinline__ void xcd_barrier_complete(unsigned* bar, unsigned x, unsigned& nloc, unsigned& nx) {
    const unsigned G = gridDim.x * gridDim.y * gridDim.z;
    unsigned sum, cnt, mine, sp = 0u;
    for (;;) {
        sum = 0u; cnt = 0u; mine = 0u;
#pragma unroll
        for (unsigned j = 0; j < 16; ++j) { const unsigned c = xb_ld(&bar[XB_XCNT(j)]); sum += c; cnt += (c > 0u) ? 1u : 0u; mine = (j == x) ? c : mine; }
        if (sum == G) break;
        __builtin_amdgcn_s_sleep(1);
        if ((++sp & 255u) == 0u) { if (xb_ld(&bar[XB_TMO])) break; if (sp > XB_SPIN_CAP) { atomicAdd(&bar[XB_TMO], 1u); break; } }
    }
    nloc = mine > 0u ? mine : 1u; nx = cnt > 0u ? cnt : 1u;
}

__device__ __forceinline__ void xcd_barrier(const XcdBarrier& b) {
    asm volatile("s_waitcnt vmcnt(0)" ::: "memory");
    __syncthreads();
    if (threadIdx.x == 0) {
        unsigned* bar = b.bar;
        __builtin_amdgcn_s_waitcnt(0);
        unsigned nloc = b.st[0], nx = b.st[1];
        if (nloc == 0u) { xcd_barrier_complete(bar, b.x, nloc, nx); b.st[0] = nloc; b.st[1] = nx; }
        const unsigned old = xb_add(&bar[XB_XSUB(b.x)], 1u);
        const unsigned gen = old / nloc;
        if (old + 1u == (gen + 1u) * nloc) {
            __builtin_amdgcn_fence(__ATOMIC_RELEASE, "agent");
            asm volatile("s_waitcnt vmcnt(0)" ::: "memory");
            const unsigned og = xb_add(&bar[XB_TOP], 1u);
            const unsigned tg = og / nx;
            if (og + 1u == (tg + 1u) * nx) xb_add(&bar[XB_TOPGEN], 1u);
            else XB_SPIN(xb_ld(&bar[XB_TOPGEN]) == tg, bar);
            __builtin_amdgcn_fence(__ATOMIC_ACQUIRE, "agent");
            xb_add(&bar[XB_XGEN(b.x)], 1u);
            asm volatile("s_waitcnt vmcnt(0)" ::: "memory");
        } else {
            XB_SPIN(xb_ld(&bar[XB_XGEN(b.x)]) == gen, bar);
            __builtin_amdgcn_fence(__ATOMIC_ACQUIRE, "agent");
            asm volatile("s_waitcnt vmcnt(0)" ::: "memory");
        }
    }
    __syncthreads();
}

__device__ __forceinline__ int src_col(int n) {
    if (n < 2048) return n;
    if (n < 4096) { const int cb = (n - 2048) >> 8, off = (n - 2048) & 255;
        return off < 128 ? 2056 + 128 * cb + off : 3080 + 128 * cb + (off - 128); }
    if (n < 5120) return 4104 + (n - 4096);
    return 5128 + (n - 5120);
}
__device__ __forceinline__ void transpose_item(const float* W, int ldw, int K, int srccol, u16* WT, int dstrow, LAS float* scr, int k0, int lane, int k0src, const float* rs) {
#pragma unroll 8
    for (int i = 0; i < 32; ++i) { const int kk = 2 * i + (lane >> 5); float v = W[(size_t)(k0src + kk) * ldw + srccol + (lane & 31)]; if (rs) v *= rs[k0 + kk]; scr[kk * 33 + (lane & 31)] = v; }
    LDS_WAIT();
    const int c = lane & 7;
#pragma unroll
    for (int j = 0; j < 4; ++j) { const int n = (lane >> 3) + 8 * j; const LAS float* s = scr + (8 * c) * 33 + n;
        u32x4 o; o.x = pk2(s[0 * 33], s[1 * 33]); o.y = pk2(s[2 * 33], s[3 * 33]); o.z = pk2(s[4 * 33], s[5 * 33]); o.w = pk2(s[6 * 33], s[7 * 33]);
        *(u32x4*)(WT + (size_t)(dstrow + n) * K + k0 + 8 * c) = o; }
    LDS_WAIT();
}

__device__ __forceinline__ void phase0(const Params& p, LAS unsigned char* lds) {
    const int tid = threadIdx.x, lane = tid & 63, wave = tid >> 6;
    const int gw = blockIdx.x * 8 + wave, NGW = gridDim.x * 8;
    u16* WtIn = (u16*)(p.ws + WS_WTIN); u16* WtOut = (u16*)(p.ws + WS_WTOUT);
    {
        LAS float* scr = (LAS float*)(lds + wave * 16384);
        constexpr int I_IN = 16 * 208, I_OUT = 32 * 32;
        for (int it = gw; it < I_IN + I_OUT; it += NGW) {
            if (it < I_IN) { const int kb = it / 208, nb = it % 208; transpose_item(p.w_in, DIN, 1024, src_col(32 * nb), WtIn, 32 * nb, scr, 64 * kb, lane, 64 * kb, nullptr); }
            else { const int r = it - I_IN; const int kb = r / 32, nb = r % 32; transpose_item(p.w_out, 1024, 2048, 32 * nb, WtOut, 32 * nb, scr, 64 * kb, lane, 64 * kb, kb >= 16 ? p.snw - 1024 : nullptr); }
        }
    }
    __syncthreads();
    LAS float* wg = (LAS float*)lds;
    for (int idx = tid; idx < 1024 * 24; idx += NTHR) {
        const int k = idx / 24, gc = idx % 24; const int col = gc < 8 ? 2048 + gc : 6664 + (gc - 8);
        const float v = p.w_in[(size_t)k * DIN + col];
        const int ln = (k & 255) >> 2, e = k & 3, j = k >> 8, c4 = gc >> 2, cm = gc & 3;
        wg[((((j * 4 + e) * 6 + c4) * 64 + ln) << 2) + cm] = v;
    }
    __syncthreads();
    u16* H = (u16*)(p.ws + WS_H); float* G = (float*)(p.ws + WS_G);
    f32x4 nw[4];
#pragma unroll
    for (int j = 0; j < 4; ++j) nw[j] = ((const f32x4*)p.norm_w)[lane + 64 * j];
    f32x4 vn[2][4];
#pragma unroll
    for (int r = 0; r < 2; ++r)
#pragma unroll
        for (int j = 0; j < 4; ++j) vn[r][j] = __builtin_nontemporal_load((const f32x4*)(p.x + (size_t)(2 * gw + r) * DM) + lane + 64 * j);
    for (int pr = gw; pr < T / 2; pr += NGW) {
        f32x4 v[2][4];
#pragma unroll
        for (int r = 0; r < 2; ++r)
#pragma unroll
            for (int j = 0; j < 4; ++j) v[r][j] = vn[r][j];
        { const int prn = (pr + NGW < T / 2) ? pr + NGW : pr;
#pragma unroll
          for (int r = 0; r < 2; ++r)
#pragma unroll
            for (int j = 0; j < 4; ++j) vn[r][j] = __builtin_nontemporal_load((const f32x4*)(p.x + (size_t)(2 * prn + r) * DM) + lane + 64 * j); }
#pragma unroll
        for (int r = 0; r < 2; ++r) {
            float s = 0.f;
#pragma unroll
            for (int j = 0; j < 4; ++j) s += (v[r][j].x * v[r][j].x + v[r][j].y * v[r][j].y) + (v[r][j].z * v[r][j].z + v[r][j].w * v[r][j].w);
            const float rstd = rsqrtf(wave_sum(s) * (1.f / DM) + EPS);
            u32x2* o8 = (u32x2*)(H + (size_t)(2 * pr + r) * DM) + lane;
#pragma unroll
            for (int j = 0; j < 4; ++j) { v[r][j] = v[r][j] * rstd * nw[j]; u32x2 o; o.x = pk2(v[r][j].x, v[r][j].y); o.y = pk2(v[r][j].z, v[r][j].w); o8[64 * j] = o; }
        }
        f32x2 a2[2][12];
#pragma unroll
        for (int i = 0; i < 12; ++i) { a2[0][i] = (f32x2){0.f, 0.f}; a2[1][i] = (f32x2){0.f, 0.f}; }
#pragma unroll
        for (int j = 0; j < 4; ++j)
#pragma unroll
            for (int e = 0; e < 4; ++e) {
                asm volatile("" ::: "memory");
#pragma unroll
                for (int c4 = 0; c4 < 6; ++c4) {
                    const f32x4 w = *(const LAS f32x4*)(wg + ((((j * 4 + e) * 6 + c4) * 64 + lane) << 2));
                    const f32x2 wlo = {w.x, w.y}, whi = {w.z, w.w};
                    const f32x2 h0 = {v[0][j][e], v[0][j][e]}, h1 = {v[1][j][e], v[1][j][e]};
                    a2[0][c4 * 2] = __builtin_elementwise_fma(h0, wlo, a2[0][c4 * 2]); a2[0][c4 * 2 + 1] = __builtin_elementwise_fma(h0, whi, a2[0][c4 * 2 + 1]);
                    a2[1][c4 * 2] = __builtin_elementwise_fma(h1, wlo, a2[1][c4 * 2]); a2[1][c4 * 2 + 1] = __builtin_elementwise_fma(h1, whi, a2[1][c4 * 2 + 1]);
                } }
        float a[48];
#pragma unroll
        for (int i = 0; i < 24; ++i) { a[i] = a2[0][i >> 1][i & 1]; a[24 + i] = a2[1][i >> 1][i & 1]; }
        float b24[24], b12[12], b6[6], b3[3];
        { const bool hi = (lane & 32) != 0;
#pragma unroll
          for (int i = 0; i < 24; ++i) { const float snd = hi ? a[i] : a[i + 24], kp = hi ? a[i + 24] : a[i]; b24[i] = kp + __shfl_xor(snd, 32); } }
        { const bool hi = (lane & 16) != 0;
#pragma unroll
          for (int i = 0; i < 12; ++i) { const float snd = hi ? b24[i] : b24[i + 12], kp = hi ? b24[i + 12] : b24[i]; b12[i] = kp + __shfl_xor(snd, 16); } }
        { const bool hi = (lane & 8) != 0;
#pragma unroll
          for (int i = 0; i < 6; ++i) { const float snd = hi ? b12[i] : b12[i + 6], kp = hi ? b12[i + 6] : b12[i]; b6[i] = kp + __shfl_xor(snd, 8); } }
        { const bool hi = (lane & 4) != 0;
#pragma unroll
          for (int i = 0; i < 3; ++i) { const float snd = hi ? b6[i] : b6[i + 3], kp = hi ? b6[i + 3] : b6[i]; b3[i] = kp + __shfl_xor(snd, 4); } }
#pragma unroll
        for (int i = 0; i < 3; ++i) { b3[i] += __shfl_xor(b3[i], 2); b3[i] += __shfl_xor(b3[i], 1); }
        if ((lane & 3) == 0) {
            const int base = ((lane >> 5) & 1) * 24 + ((lane >> 4) & 1) * 12 + ((lane >> 3) & 1) * 6 + ((lane >> 2) & 1) * 3;
#pragma unroll
            for (int i = 0; i < 3; ++i) { const int idx = base + i; const int r = idx / 24, gc = idx % 24; G[(size_t)(2 * pr + r) * NGT + gc] = b3[i]; }
        }
    }
}

__device__ __forceinline__ float scan128_sum(float v, LAS float* s_tot) {
    const int lane = threadIdx.x & 63;
#pragma unroll
    for (int o = 1; o < 64; o <<= 1) { const float t = __shfl_up(v, o); if (lane >= o) v += t; }
    if (threadIdx.x == 63) *s_tot = v;
    __syncthreads();
    if (threadIdx.x >= 64 && threadIdx.x < 128) v += *s_tot;
    return v;
}
__device__ __forceinline__ float scan128_max(float v, LAS float* s_tot) {
    const int lane = threadIdx.x & 63;
#pragma unroll
    for (int o = 1; o < 64; o <<= 1) { const float t = __shfl_up(v, o); if (lane >= o) v = fmaxf(v, t); }
    if (threadIdx.x == 63) *s_tot = v;
    __syncthreads();
    if (threadIdx.x >= 64 && threadIdx.x < 128) v = fmaxf(v, *s_tot);
    return v;
}
__device__ __forceinline__ void mlstm_gates(float ipr, float fpr, LAS float* s_li, LAS float* s_lf, LAS float* s_b) {
    const int tid = threadIdx.x;
    float lf = 0.f;
    if (tid < CL) {
        const float fc = softcap(fpr);
        s_li[tid] = softcap(ipr);
        lf = fminf(fc, 0.f) - log1pf(expf(-fabsf(fc)));
    }
    const float b = scan128_sum(lf, s_lf);
    if (tid < CL) s_b[tid] = b;
    __syncthreads();
}
__device__ __forceinline__ void ssd_gates(const Params& p, int t0, int g, LAS float* s_dt, LAS float* s_ac, LAS float* s_tmp) {
    const int tid = threadIdx.x, lane = tid & 63, hh = tid >> 6, head = g * 8 + hh; const float* G = (const float*)(p.ws + WS_G);
    const float g0 = G[(size_t)(t0 + lane) * NGT + 8 + head], g1 = G[(size_t)(t0 + lane + 64) * NGT + 8 + head];
    const float db = p.dt_bias[head], A = -expf(p.a_log[head]);
    float carry = 0.f;
#pragma unroll
    for (int hf = 0; hf < 2; ++hf) { const int s = lane + 64 * hf;
        const float dtv = softplusf((hf ? g1 : g0) + db);
        float v = dtv * A;
#pragma unroll
        for (int o = 1; o < 64; o <<= 1) { const float t = __shfl_up(v, o); if (lane >= o) v += t; }
        v += carry; carry = __shfl(v, 63);
        s_dt[hh * 128 + s] = dtv; s_ac[hh * 128 + s] = v; }
    __syncthreads();
}
struct ConvW { f32x4 w[8]; float b[8]; };
__device__ __forceinline__ void conv_load(const Params& p, int ch, ConvW& cw) {
#pragma unroll
    for (int i = 0; i < 8; ++i) { cw.w[i] = ((const f32x4*)p.conv_w)[ch + i]; cw.b[i] = p.conv_b[ch + i]; }
}
__device__ __forceinline__ void conv8(const u16* P, const ConvW& cw, int t, int tl, int ch, float* out) {
    u32x4 v[4];
#pragma unroll
    for (int w = 0; w < 4; ++w) { const int d = 3 - w, dd = (tl >= d) ? d : 0; v[w] = *(const u32x4*)(P + (size_t)(t - dd) * LDP + PX + ch); }
    float acc[8];
#pragma unroll
    for (int i = 0; i < 8; ++i) acc[i] = cw.b[i];
#pragma unroll
    for (int w = 0; w < 4; ++w) { const float m = (tl >= 3 - w) ? 1.f : 0.f; float f[8]; unpack8(v[w], f);
#pragma unroll
        for (int i = 0; i < 8; ++i) acc[i] += f[i] * (cw.w[i][w] * m); }
#pragma unroll
    for (int i = 0; i < 8; ++i) out[i] = siluf(acc[i]);
}


__device__ __forceinline__ void conv_roll_load(const u16* P, int t0, int tl0, int s0, int ch, u32x4* raw) {
#pragma unroll
    for (int k = 0; k < 11; ++k) { const int tl = tl0 + s0 - 3 + k; const int rr = tl >= 0 ? t0 + s0 - 3 + k : t0; raw[k] = *(const u32x4*)(P + (size_t)rr * LDP + PX + ch); }
}
__device__ __forceinline__ void conv_roll_row(const u32x4* raw, const ConvW& cw, int j, float m0, float* acc) {
#pragma unroll
    for (int e = 0; e < 8; ++e) acc[e] = cw.b[e];
#pragma unroll
    for (int w = 0; w < 4; ++w) { const float mm = (j + w < 3) ? m0 : 1.f; float f[8]; unpack8(raw[j + w], f);
#pragma unroll
        for (int e = 0; e < 8; ++e) acc[e] += f[e] * (cw.w[e][w] * mm); }
#pragma unroll
    for (int e = 0; e < 8; ++e) acc[e] = siluf(acc[e]);
}

constexpr int LP = 136;
struct M2Pre { float ipr, fpr; u32x4 kv[4], vv[8]; };
__device__ __forceinline__ void m2_load(const Params& p, int item, M2Pre& r) {
    const int tid = threadIdx.x, h = item & 3, t0 = (item >> 2) * CL, ss = tid >> 2, part = tid & 3;
    const u16* P = (const u16*)(p.ws + WS_P); const float* G = (const float*)(p.ws + WS_G);
    r.ipr = 0.f; r.fpr = 0.f;
    if (tid < CL) { r.ipr = G[(size_t)(t0 + tid) * NGT + h]; r.fpr = G[(size_t)(t0 + tid) * NGT + 4 + h]; }
    const u16* kr = P + (size_t)(t0 + ss) * LDP + PK + h * 128 + part * 32;
    const u16* vr = P + (size_t)(t0 + ss) * LDP + PV + h * 256 + part * 64;
#pragma unroll
    for (int c = 0; c < 4; ++c) r.kv[c] = *(const u32x4*)(kr + c * 8);
#pragma unroll
    for (int c = 0; c < 8; ++c) r.vv[c] = *(const u32x4*)(vr + c * 8);
}
__device__ __forceinline__ void phase2_mlstm(const Params& p, LAS unsigned char* lds, int item, M2Pre& pre, int next_item) {
    const int tid = threadIdx.x, lane = tid & 63, wave = tid >> 6;
    const int h = item & 3, bc = item >> 2, t0 = bc * CL;
    LAS u16* KT = (LAS u16*)lds;
    LAS u16* VT = (LAS u16*)(lds + 34816);
    LAS float* sm = (LAS float*)(lds + 34816 + 67584);
    LAS float *s_li = sm, *s_lf = sm + 128, *s_b = sm + 256, *s_w = sm + 384;
    const float bi_h = p.b_i[h], bf_h = p.b_f[h];
    const int ss = tid >> 2, part = tid & 3;
    const float ipr = pre.ipr, fpr = pre.fpr;
    float li = 0.f, lf = 0.f;
    if (tid < CL) { const float fc = softcap(fpr + bf_h); li = softcap(ipr + bi_h); lf = fminf(fc, 0.f) - log1pf(expf(-fabsf(fc))); }
    const float bcum = scan128_sum(lf, s_lf);
    float uv = -3.0e38f;
    if (tid < CL) { uv = li - bcum; ((float*)(p.ws + WS_LU))[(size_t)item * 128 + tid] = uv; ((float*)(p.ws + WS_LB))[(size_t)item * 128 + tid] = bcum; }
    float um = uv;
#pragma unroll
    for (int o = 1; o < 64; o <<= 1) um = fmaxf(um, __shfl_xor(um, o));
    if (lane == 0 && wave < 2) s_li[wave] = um;
    if (tid < CL) s_w[tid] = uv;
    __syncthreads();
    const float umax = fmaxf(s_li[0], s_li[1]);
    if (tid == CL - 1) { ((float*)(p.ws + WS_MBL))[item] = bcum; ((float*)(p.ws + WS_MGM))[item] = bcum + umax; }
    (void)s_b;
    {
        const float w = expf(s_w[ss] - umax);
#pragma unroll
        for (int c = 0; c < 4; ++c) { float f[8]; unpack8(pre.kv[c], f);
            u32x4 o; o.x = pk2(f[0] * w, f[1] * w); o.y = pk2(f[2] * w, f[3] * w); o.z = pk2(f[4] * w, f[5] * w); o.w = pk2(f[6] * w, f[7] * w);
            *(LAS u32x4*)(KT + ss * LP + part * 32 + c * 8) = o; }
#pragma unroll
        for (int c = 0; c < 8; ++c) *(LAS u32x4*)(VT + ss * 264 + part * 64 + c * 8) = pre.vv[c];
    }
    m2_load(p, next_item, pre);
    __syncthreads();
    {
        f32x4 nacc = {0.f, 0.f, 0.f, 0.f};
        const bf16x8 ones = {(short)0x3F80, (short)0x3F80, (short)0x3F80, (short)0x3F80, (short)0x3F80, (short)0x3F80, (short)0x3F80, (short)0x3F80};
#pragma unroll
        for (int ks = 0; ks < 4; ++ks) nacc = __builtin_amdgcn_mfma_f32_16x16x32_bf16(ones, frag_tr(KT, LP, ks * 32, wave * 16, lane), nacc, 0, 0, 0);
        if ((lane >> 4) == 0) ((float*)(p.ws + WS_NLOC))[(size_t)item * 128 + wave * 16 + (lane & 15)] = nacc[0];
    }
    f32x4 acc[8][2];
#pragma unroll
    for (int m = 0; m < 8; ++m)
#pragma unroll
        for (int n = 0; n < 2; ++n) acc[m][n] = (f32x4){0.f, 0.f, 0.f, 0.f};
    mma_lds_tt<8, 2, 4>(acc, KT, LP, VT + wave * 32, 264, lane);
    u16* CS = (u16*)p.out + (size_t)item * 32768;
    const int r = lane & 15, q = lane >> 4;
    {
        u16* dst = CS + (wave * 32 + (q & 1) * 16 + r) * 128 + (q >> 1) * 8;
#pragma unroll
        for (int m = 0; m < 8; ++m) {
            unsigned x0 = pk2(acc[m][0][0], acc[m][0][1]), x1 = pk2(acc[m][0][2], acc[m][0][3]);
            unsigned y0 = pk2(acc[m][1][0], acc[m][1][1]), y1 = pk2(acc[m][1][2], acc[m][1][3]);
            auto s0 = __builtin_amdgcn_permlane16_swap(x0, y0, false, false); x0 = s0[0]; y0 = s0[1];
            auto s1 = __builtin_amdgcn_permlane16_swap(x1, y1, false, false); x1 = s1[0]; y1 = s1[1];
            const u32x4 o = {x0, x1, y0, y1};
            *(u32x4*)(dst + m * 16) = o;
        }
    }
    __syncthreads();
}

__device__ __forceinline__ void phase2_ssd(const Params& p, LAS unsigned char* lds, int item) {
    const int tid = threadIdx.x, lane = tid & 63, wave = tid >> 6;
    const int g = item & 1, bc = item >> 1, t0 = bc * CL, tl0 = (bc & (NCH - 1)) * CL;
    const u16* P = (const u16*)(p.ws + WS_P); u16* XC = (u16*)(p.ws + WS_H);
    LAS u16* BN = (LAS u16*)lds;
    LAS u16* XD = (LAS u16*)(lds + 34816);
    LAS float* sm = (LAS float*)(lds + 34816 + 67584);
    LAS float *s_dt = sm, *s_ac = sm + 1024;
    const int cg = tid & 31, s0 = (tid >> 5) * 8;
    u32x4 raw[11];
#define SSD2_LOAD(half) do { _Pragma("unroll") for (int k = 0; k < 11; ++k) { const int tl = tl0 + s0 - 3 + k; const int rr = tl >= 0 ? t0 + s0 - 3 + k : t0; \
        raw[k] = *(const u32x4*)(P + (size_t)rr * LDP + PX + g * 512 + (half) * 256 + cg * 8); } } while (0)
    SSD2_LOAD(0);
    ssd_gates(p, t0, g, s_dt, s_ac, sm + 2048);
    { float* sg = (float*)(p.ws + WS_SG) + (size_t)item * 2048; sg[tid] = s_dt[tid]; sg[tid + 512] = s_dt[tid + 512]; sg[1024 + tid] = s_ac[tid]; sg[1536 + tid] = s_ac[tid + 512]; }
    if (tid < 8) ((float*)(p.ws + WS_SDEC))[item * 8 + tid] = expf(s_ac[tid * 128 + 127]);
    if (tid < 256) {
        const int cgp = tid & 15, sb = (tid >> 4) * 8, chb = 1024 + g * 128 + cgp * 8;
        u32x4 rawb[11]; conv_roll_load(P, t0, tl0, sb, chb, rawb);
        ConvW cw; conv_load(p, chb, cw);
        const float m0 = (tl0 + sb - 3 >= 0) ? 1.f : 0.f;
#pragma unroll
        for (int j = 0; j < 8; ++j) { float f[8]; conv_roll_row(rawb, cw, j, m0, f);
            u32x4 o; o.x = pk2(f[0], f[1]); o.y = pk2(f[2], f[3]); o.z = pk2(f[4], f[5]); o.w = pk2(f[6], f[7]); *(LAS u32x4*)(BN + (sb + j) * LP + cgp * 8) = o; }
    }
    u16* HS = (u16*)p.out + (size_t)1024 * 32768;
    const int r = lane & 15, q = lane >> 4;
#pragma unroll 1
    for (int hb = 0; hb < 2; ++hb) {
        {
            const int ch = g * 512 + hb * 256 + cg * 8, hh = hb * 4 + (cg >> 3);
            ConvW cw; conv_load(p, ch, cw);
            const float alast = s_ac[hh * 128 + 127];
            float m0 = (tl0 + s0 - 3 >= 0) ? 1.f : 0.f;
#pragma unroll
            for (int j = 0; j < 8; ++j) {
                float acc[8];
#pragma unroll
                for (int e = 0; e < 8; ++e) acc[e] = cw.b[e];
#pragma unroll
                for (int w = 0; w < 4; ++w) { const float mm = (j + w < 3) ? m0 : 1.f; float f[8]; unpack8(raw[j + w], f);
#pragma unroll
                    for (int e = 0; e < 8; ++e) acc[e] += f[e] * (cw.w[e][w] * mm); }
#pragma unroll
                for (int e = 0; e < 8; ++e) acc[e] = siluf(acc[e]);
                const int sr = s0 + j; const float sc = s_dt[hh * 128 + sr] * expf(alast - s_ac[hh * 128 + sr]);
                u32x4 o; o.x = pk2(acc[0], acc[1]); o.y = pk2(acc[2], acc[3]); o.z = pk2(acc[4], acc[5]); o.w = pk2(acc[6], acc[7]);
                *(u32x4*)(XC + (size_t)(t0 + sr) * 1024 + ch) = o;
                o.x = pk2(acc[0] * sc, acc[1] * sc); o.y = pk2(acc[2] * sc, acc[3] * sc); o.z = pk2(acc[4] * sc, acc[5] * sc); o.w = pk2(acc[6] * sc, acc[7] * sc);
                *(LAS u32x4*)(XD + sr * 264 + cg * 8) = o;
            }
        }
        if (hb == 0) SSD2_LOAD(1);
        __syncthreads();
        const int h4 = wave >> 1, nh = wave & 1, head = g * 8 + hb * 4 + h4;
        f32x4 acc[4][4];
#pragma unroll
        for (int m = 0; m < 4; ++m)
#pragma unroll
            for (int n = 0; n < 4; ++n) acc[m][n] = (f32x4){0.f, 0.f, 0.f, 0.f};
        mma_lds_tt<4, 4, 4>(acc, BN + nh * 64, LP, XD + h4 * 64, 264, lane);
        u16* dst = HS + ((size_t)bc * 16 + head) * 8192;
#pragma unroll
        for (int m = 0; m < 4; ++m)
#pragma unroll
            for (int n2 = 0; n2 < 4; n2 += 2) {
                unsigned x0 = pk2(acc[m][n2][0], acc[m][n2][1]), x1 = pk2(acc[m][n2][2], acc[m][n2][3]);
                unsigned y0 = pk2(acc[m][n2 + 1][0], acc[m][n2 + 1][1]), y1 = pk2(acc[m][n2 + 1][2], acc[m][n2 + 1][3]);
                auto s0 = __builtin_amdgcn_permlane16_swap(x0, y0, false, false); x0 = s0[0]; y0 = s0[1];
                auto s1 = __builtin_amdgcn_permlane16_swap(x1, y1, false, false); x1 = s1[0]; y1 = s1[1];
                const u32x4 o = {x0, x1, y0, y1};
                *(u32x4*)(dst + ((n2 + (q & 1)) * 16 + r) * 128 + nh * 64 + m * 16 + (q >> 1) * 8) = o; }
        __syncthreads();
    }
#undef SSD2_LOAD
}

__device__ __forceinline__ void phase3(const Params& p) {
    const int gtid = blockIdx.x * NTHR + threadIdx.x, nthr = gridDim.x * NTHR;
    for (int w = gtid; w < 131072; w += nthr) {
        if (w < 65536) {
            const int bh = w >> 12, e8 = w & 4095, b = bh >> 2, h = bh & 3;
            u16* CS = (u16*)p.out; const float* MBL = (const float*)(p.ws + WS_MBL); const float* MGM = (const float*)(p.ws + WS_MGM);
            float* MPREV = (float*)(p.ws + WS_MPREV); float* NL = (float*)(p.ws + WS_NLOC);
            float C[8]; float m = 0.f;
#pragma unroll
            for (int i = 0; i < 8; ++i) C[i] = 0.f;
            u32x4 vn[8]; float an[8], gn[8], nn[8]; float nv = 0.f; const int en = e8 & 127;
#define P3_LOAD(c0_) do { _Pragma("unroll") for (int j = 0; j < 8; ++j) { const int it_ = (b * NCH + (c0_) + j) * 4 + h; vn[j] = *(const u32x4*)(CS + (size_t)it_ * 32768 + e8 * 8); an[j] = MBL[it_]; gn[j] = MGM[it_]; nn[j] = NL[(size_t)it_ * 128 + en]; } } while (0)
            P3_LOAD(0);
#pragma unroll 1
            for (int c0 = 0; c0 < NCH; c0 += 8) {
                u32x4 v[8]; float av[8], gv[8], nl[8];
#pragma unroll
                for (int j = 0; j < 8; ++j) { v[j] = vn[j]; av[j] = an[j]; gv[j] = gn[j]; nl[j] = nn[j]; }
                if (c0 + 8 < NCH) P3_LOAD(c0 + 8);
#pragma unroll
                for (int j = 0; j < 8; ++j) {
                    const int item = (b * NCH + c0 + j) * 4 + h;
                    const float a = av[j], gm = gv[j];
                    const float mn = fmaxf(a + m, gm), so = __expf(a + m - mn), sl = __expf(gm - mn);
                    float f[8]; unpack8(v[j], f);
                    u32x4 o; o.x = pk2(C[0], C[1]); o.y = pk2(C[2], C[3]); o.z = pk2(C[4], C[5]); o.w = pk2(C[6], C[7]);
                    *(u32x4*)(CS + (size_t)item * 32768 + e8 * 8) = o;
#pragma unroll
                    for (int i = 0; i < 8; ++i) C[i] = so * C[i] + sl * f[i];
                    if (e8 < 128) { NL[(size_t)item * 128 + e8] = nv; if (e8 == 0) MPREV[item] = m; }
                    nv = so * nv + sl * nl[j];
                    m = mn;
                }
            }
#undef P3_LOAD
        } else {
            const int idx = w - 65536, bhd = idx >> 10, e8 = idx & 1023, b = bhd >> 4, head = bhd & 15;
            u16* HS = (u16*)p.out + (size_t)1024 * 32768; const float* SD = (const float*)(p.ws + WS_SDEC);
            float hs[8];
#pragma unroll
            for (int i = 0; i < 8; ++i) hs[i] = 0.f;
            u32x4 vn[8]; float dn[8];
#define P3_LOAD(c0_) do { _Pragma("unroll") for (int j = 0; j < 8; ++j) { const int bc_ = b * NCH + (c0_) + j; vn[j] = *(const u32x4*)(HS + ((size_t)bc_ * 16 + head) * 8192 + e8 * 8); dn[j] = SD[(bc_ * 2 + (head >> 3)) * 8 + (head & 7)]; } } while (0)
            P3_LOAD(0);
#pragma unroll 1
            for (int c0 = 0; c0 < NCH; c0 += 8) {
                u32x4 v[8]; float dv[8];
#pragma unroll
                for (int j = 0; j < 8; ++j) { v[j] = vn[j]; dv[j] = dn[j]; }
                if (c0 + 8 < NCH) P3_LOAD(c0 + 8);
#pragma unroll
                for (int j = 0; j < 8; ++j) {
                    const int bc = b * NCH + c0 + j;
                    float f[8]; unpack8(v[j], f);
                    u32x4 o; o.x = pk2(hs[0], hs[1]); o.y = pk2(hs[2], hs[3]); o.z = pk2(hs[4], hs[5]); o.w = pk2(hs[6], hs[7]);
                    *(u32x4*)(HS + ((size_t)bc * 16 + head) * 8192 + e8 * 8) = o;
#pragma unroll
                    for (int i = 0; i < 8; ++i) hs[i] = dv[j] * hs[i] + f[i];
                }
            }
#undef P3_LOAD
        }
    }
}

struct M4Pre { float ipr, fpr, npv, mprev; u32x4 qv[4], kv[4]; };
__device__ __forceinline__ void m4_load(const Params& p, int item, M4Pre& r) {
    const int tid = threadIdx.x, h = item & 3, t0 = (item >> 2) * CL, ss = tid >> 2, part = tid & 3;
    const u16* prow = (const u16*)(p.ws + WS_P) + (size_t)(t0 + ss) * LDP; const float* G = (const float*)(p.ws + WS_G);
    r.ipr = 0.f; r.fpr = 0.f; r.npv = 0.f;
    if (tid < CL) { r.ipr = ((const float*)(p.ws + WS_LU))[(size_t)item * 128 + tid]; r.fpr = ((const float*)(p.ws + WS_LB))[(size_t)item * 128 + tid]; r.npv = ((const float*)(p.ws + WS_NLOC))[(size_t)item * 128 + tid]; }
    (void)G;
    r.mprev = ((const float*)(p.ws + WS_MPREV))[item];
#pragma unroll
    for (int c = 0; c < 4; ++c) { r.qv[c] = *(const u32x4*)(prow + PQ + h * 128 + part * 32 + c * 8); r.kv[c] = *(const u32x4*)(prow + PK + h * 128 + part * 32 + c * 8); }
}
__device__ __forceinline__ void phase4_mlstm(const Params& p, LAS unsigned char* lds, int item, M4Pre& pre, int next_item, bool first) {
    const int tid = threadIdx.x, lane = tid & 63, wave = tid >> 6;
    const int h = item & 3, bc = item >> 2, t0 = bc * CL;
    u16* P = (u16*)(p.ws + WS_P); const float* G = (const float*)(p.ws + WS_G);
    LAS u16* Q = (LAS u16*)lds;
    LAS u16* KS = (LAS u16*)(lds + 34816);
    LAS u16* VT = (LAS u16*)(lds + 69632);
    LAS u16* CP = (LAS u16*)(lds + 104448);
    LAS float* HB = (LAS float*)lds;
    LAS float* sm = (LAS float*)(lds + 139264);
    LAS float *s_li = sm, *s_lf = sm + 128, *s_b = sm + 256, *s_u = sm + 384, *s_M = sm + 512, *s_np = sm + 768;
    const int ss = tid >> 2, part = tid & 3;
    const u16* CS = (const u16*)p.out + (size_t)item * 32768;
    const u16* prow = P + (size_t)(t0 + ss) * LDP;
    const float ipr = pre.ipr, fpr = pre.fpr, npv = pre.npv, mprev = pre.mprev;
    if (first) { if (tid < 256) sm[896 + tid] = p.mnw[h * 256 + tid]; }
    float uv = -3.0e38f;
    if (tid < CL) { uv = ipr; s_u[tid] = uv; s_b[tid] = fpr; s_np[tid] = npv; }
    (void)s_li;
#pragma unroll
    for (int c = 0; c < 4; ++c) { *(LAS u32x4*)(Q + ss * LP + part * 32 + c * 8) = pre.qv[c]; *(LAS u32x4*)(KS + ss * LP + part * 32 + c * 8) = pre.kv[c]; }
    u32x4 vv[4], cv[4];
#pragma unroll
    for (int c = 0; c < 4; ++c) { vv[c] = *(const u32x4*)(prow + PV + h * 256 + part * 32 + c * 8); cv[c] = *(const u32x4*)(CS + (size_t)ss * 128 + part * 32 + c * 8); }
    const float pm = scan128_max(uv, s_lf);
    if (tid < CL) s_M[tid] = fmaxf(mprev, pm);
    const int r = lane & 15, q = lane >> 4;
    f32x4 qnacc = {0.f, 0.f, 0.f, 0.f};
#pragma unroll
    for (int ks = 0; ks < 4; ++ks) {
        const f32x4 n0 = *(const LAS f32x4*)(s_np + ks * 32 + q * 8), n1 = *(const LAS f32x4*)(s_np + ks * 32 + q * 8 + 4);
        const u32x4 nb = {pk2(n0.x, n0.y), pk2(n0.z, n0.w), pk2(n1.x, n1.y), pk2(n1.z, n1.w)};
        qnacc = __builtin_amdgcn_mfma_f32_16x16x32_bf16(*(const LAS bf16x8*)(Q + (wave * 16 + r) * LP + ks * 32 + q * 8), __builtin_bit_cast(bf16x8, nb), qnacc, 0, 0, 0);
    }
    f32x4 sacc[1][8];
#pragma unroll
    for (int n = 0; n < 8; ++n) sacc[0][n] = (f32x4){0.f, 0.f, 0.f, 0.f};
    mma_lds<1, 8, 4>(sacc, Q + wave * 16 * LP, LP, KS, LP, lane);
    __syncthreads();
    float den[4] = {0.f, 0.f, 0.f, 0.f};
    {
        float Mr[4];
#pragma unroll
        for (int i = 0; i < 4; ++i) Mr[i] = s_M[wave * 16 + q * 4 + i];
#pragma unroll
        for (int n = 0; n < 8; ++n) { const int s = n * 16 + r; const float us = s_u[s];
#pragma unroll
            for (int i = 0; i < 4; ++i) { const int j = wave * 16 + q * 4 + i; float wgt = __expf(fminf(us - Mr[i], 0.f)); wgt = (s <= j) ? wgt : 0.f; const float sp = sacc[0][n][i] * wgt; den[i] += sp;
                KS[j * LP + s] = f2bf(sp); } }
    }
#pragma unroll
    for (int i = 0; i < 4; ++i) { den[i] += __shfl_xor(den[i], 1); den[i] += __shfl_xor(den[i], 2); den[i] += __shfl_xor(den[i], 4); den[i] += __shfl_xor(den[i], 8); }
    float isc[4], Mj[4], bj[4], qn[4];
#pragma unroll
    for (int i = 0; i < 4; ++i) { const int j = wave * 16 + q * 4 + i; Mj[i] = s_M[j]; bj[i] = s_b[j]; qn[i] = qnacc[i]; isc[i] = __expf(mprev - Mj[i]); }
#pragma unroll
    for (int c = 0; c < 4; ++c) { *(LAS u32x4*)(VT + ss * LP + part * 32 + c * 8) = vv[c]; *(LAS u32x4*)(CP + ss * LP + part * 32 + c * 8) = cv[c]; }
#pragma unroll
    for (int c = 0; c < 4; ++c) { vv[c] = *(const u32x4*)(prow + PV + h * 256 + 128 + part * 32 + c * 8); cv[c] = *(const u32x4*)(CS + (size_t)(128 + ss) * 128 + part * 32 + c * 8); }
    __syncthreads();
    f32x4 acc[2][1][8];
#pragma unroll
    for (int n = 0; n < 8; ++n) acc[0][0][n] = (f32x4){0.f, 0.f, 0.f, 0.f};
    mma_lds<1, 8, 4>(acc[0], Q + wave * 16 * LP, LP, CP, LP, lane);
#pragma unroll
    for (int n = 0; n < 8; ++n)
#pragma unroll
        for (int i = 0; i < 4; ++i) acc[0][0][n][i] *= isc[i];
    mma_lds_bt<1, 8, 4>(acc[0], KS + wave * 16 * LP, LP, VT, LP, lane);
    __syncthreads();
#pragma unroll
    for (int c = 0; c < 4; ++c) { *(LAS u32x4*)(VT + ss * LP + part * 32 + c * 8) = vv[c]; *(LAS u32x4*)(CP + ss * LP + part * 32 + c * 8) = cv[c]; }
    u16* obase = P + (size_t)(t0 + (tid >> 5)) * LDP + PO + h * 256 + (tid & 31) * 8; const u16* zbase = obase + (PZM - PO);
    u32x4 zvv[8];
#pragma unroll
    for (int it = 0; it < 8; ++it) zvv[it] = *(const u32x4*)(zbase + (size_t)(16 * it) * LDP);
    __syncthreads();
#pragma unroll
    for (int n = 0; n < 8; ++n) acc[1][0][n] = (f32x4){0.f, 0.f, 0.f, 0.f};
    mma_lds<1, 8, 4>(acc[1], Q + wave * 16 * LP, LP, CP, LP, lane);
#pragma unroll
    for (int n = 0; n < 8; ++n)
#pragma unroll
        for (int i = 0; i < 4; ++i) acc[1][0][n][i] *= isc[i];
    mma_lds_bt<1, 8, 4>(acc[1], KS + wave * 16 * LP, LP, VT, LP, lane);
    const float scale = 0.08838834764831845f;
    float fac[4];
#pragma unroll
    for (int i = 0; i < 4; ++i) { const float dt = scale * (den[i] + isc[i] * qn[i]); const float dn = fmaxf(fabsf(dt), __expf(-(bj[i] + Mj[i]))); fac[i] = scale / dn; }
    __syncthreads();
#pragma unroll
    for (int hf = 0; hf < 2; ++hf)
#pragma unroll
        for (int n = 0; n < 8; ++n)
#pragma unroll
            for (int i = 0; i < 4; ++i) HB[(wave * 16 + q * 4 + i) * 260 + hf * 128 + n * 16 + r] = acc[hf][0][n][i] * fac[i];
    __syncthreads();
    m4_load(p, next_item, pre);
    {
        const int j = ss;
        float sq = 0.f;
#pragma unroll
        for (int it = 0; it < 8; ++it) { const int vd = (it * 4 + part) * 8; const f32x4 a = *(const LAS f32x4*)(HB + j * 260 + vd), b = *(const LAS f32x4*)(HB + j * 260 + vd + 4);
            sq += (a.x * a.x + a.y * a.y) + (a.z * a.z + a.w * a.w) + (b.x * b.x + b.y * b.y) + (b.z * b.z + b.w * b.w); }
        sq += __shfl_xor(sq, 1); sq += __shfl_xor(sq, 2);
        if (part == 0) s_u[j] = rsqrtf(sq * (1.f / 256.f) + EPS);
    }
    __syncthreads();
    {
        const int vd = (tid & 31) * 8;
        const f32x4 w0 = *(const LAS f32x4*)(sm + 896 + vd), w1 = *(const LAS f32x4*)(sm + 896 + vd + 4);
        const float wv[8] = {w0.x, w0.y, w0.z, w0.w, w1.x, w1.y, w1.z, w1.w};
#pragma unroll
        for (int it = 0; it < 8; ++it) { const int j = (tid >> 5) + 16 * it; const float rstd = s_u[j];
            const f32x4 a = *(const LAS f32x4*)(HB + j * 260 + vd), b = *(const LAS f32x4*)(HB + j * 260 + vd + 4);
            const float hv[8] = {a.x, a.y, a.z, a.w, b.x, b.y, b.z, b.w};
            float zf[8]; unpack8(zvv[it], zf);
            float y[8];
#pragma unroll
            for (int e = 0; e < 8; ++e) y[e] = hv[e] * rstd * wv[e] * zf[e];
            u32x4 o; o.x = pk2(y[0], y[1]); o.y = pk2(y[2], y[3]); o.z = pk2(y[4], y[5]); o.w = pk2(y[6], y[7]);
            *(u32x4*)(obase + (size_t)(16 * it) * LDP) = o; }
    }
    __syncthreads();
}

__device__ __forceinline__ void phase4_ssd(const Params& p, LAS unsigned char* lds, int item) {
    const int tid = threadIdx.x, lane = tid & 63, wave = tid >> 6;
    const int g = item & 1, bc = item >> 1, t0 = bc * CL, tl0 = (bc & (NCH - 1)) * CL;
    u16* P = (u16*)(p.ws + WS_P); const u16* XC = (const u16*)(p.ws + WS_H);
    LAS u16* CM = (LAS u16*)lds;
    LAS u16* BM = (LAS u16*)(lds + 34816);
#define SSD4_XS(b_) ((LAS u16*)(lds + 34816 + (b_) * 18432))
#define SSD4_ZS(b_) ((LAS u16*)(lds + 71680 + (b_) * 18432))
#define SSD4_HP(b_) ((LAS u16*)(lds + ((b_) ? 132640 : 108544)))
    LAS float* sm = (LAS float*)(lds + 150048);
    LAS float *s_dt = sm, *s_ac = sm + 1024, *s_rs = sm + 2048;
    const u16* HS = (const u16*)p.out + (size_t)1024 * 32768;
    u32x4 zv[2], xv[2], hv[2];
#define SSD4_LOAD(head_) do { _Pragma("unroll") for (int i = 0; i < 2; ++i) { const int ch = tid + NTHR * i, row = ch >> 3, c8 = ch & 7, pp = ch >> 4, c16 = ch & 15; \
        zv[i] = *(const u32x4*)(P + (size_t)(t0 + row) * LDP + PZS + (head_) * 64 + c8 * 8); \
        xv[i] = *(const u32x4*)(XC + (size_t)(t0 + row) * 1024 + (head_) * 64 + c8 * 8); \
        hv[i] = *(const u32x4*)(HS + ((size_t)bc * 16 + (head_)) * 8192 + pp * 128 + c16 * 8); } } while (0)
    if (tid < 8) s_rs[128 + tid] = p.d_skip[g * 8 + tid];
    { const float* sg = (const float*)(p.ws + WS_SG) + (size_t)item * 2048; const float d0 = sg[tid], d1 = sg[tid + 512], a0 = sg[1024 + tid], a1 = sg[1536 + tid];
      s_dt[tid] = d0; s_dt[tid + 512] = d1; s_ac[tid] = a0; s_ac[tid + 512] = a1; }
    __syncthreads();
    {
        const int mat = tid >> 8, t8 = tid & 255, cgp = t8 & 15, sb = (t8 >> 4) * 8, chb = 1024 + mat * 256 + g * 128 + cgp * 8;
        u32x4 rawb[11]; conv_roll_load(P, t0, tl0, sb, chb, rawb);
        ConvW cw; conv_load(p, chb, cw);
        LAS u16* dstt = mat ? CM : BM; const float m0 = (tl0 + sb - 3 >= 0) ? 1.f : 0.f;
#pragma unroll
        for (int j = 0; j < 8; ++j) { float f[8]; conv_roll_row(rawb, cw, j, m0, f);
            u32x4 o; o.x = pk2(f[0], f[1]); o.y = pk2(f[2], f[3]); o.z = pk2(f[4], f[5]); o.w = pk2(f[6], f[7]); *(LAS u32x4*)(dstt + (sb + j) * LP + cgp * 8) = o; }
    }
    SSD4_LOAD(g * 8);
    __syncthreads();
    const int r = lane & 15, q = lane >> 4;
    const int lcol = wave * 16 + r;
    f32x4 cbT[8][1];
#pragma unroll
    for (int m = 0; m < 8; ++m) cbT[m][0] = (f32x4){0.f, 0.f, 0.f, 0.f};
    mma_lds<8, 1, 4>(cbT, BM, LP, CM + wave * 16 * LP, LP, lane);
    float ssq = 0.f;
    __syncthreads();
#define SSD4_STAGE(b_) do { _Pragma("unroll") for (int i = 0; i < 2; ++i) { const int ch = tid + NTHR * i, row = ch >> 3, c8 = ch & 7, pp = ch >> 4, c16 = ch & 15; \
        *(LAS u32x4*)(SSD4_ZS(b_) + row * 72 + c8 * 8) = zv[i]; *(LAS u32x4*)(SSD4_XS(b_) + row * 72 + c8 * 8) = xv[i]; *(LAS u32x4*)(SSD4_HP(b_) + pp * LP + c16 * 8) = hv[i]; } } while (0)
    SSD4_STAGE(0); SSD4_LOAD(g * 8 + 1);
#pragma unroll 1
    for (int hh = 0; hh < 8; ++hh) {
        const int head = g * 8 + hh, cb_ = hh & 1, nb_ = cb_ ^ 1;
        LAS u16* XS = SSD4_XS(cb_); LAS u16* ZS = SSD4_ZS(cb_); LAS u16* HP = SSD4_HP(cb_);
        bf16x8 mfrag[4];
        {
            const float acl = s_ac[hh * 128 + lcol];
#pragma unroll
            for (int ks = 0; ks < 4; ++ks) {
                unsigned pk[4];
#pragma unroll
                for (int hf = 0; hf < 2; ++hf) { const int m = 2 * ks + hf, sb = 16 * m + 4 * q;
                    const f32x4 a4 = *(const LAS f32x4*)(s_ac + hh * 128 + sb), d4 = *(const LAS f32x4*)(s_dt + hh * 128 + sb);
                    float v[4];
#pragma unroll
                    for (int i = 0; i < 4; ++i) { float t = cbT[m][0][i] * __expf(fminf(acl - a4[i], 0.f)) * d4[i]; v[i] = (sb + i <= lcol) ? t : 0.f; }
                    pk[2 * hf] = pk2(v[0], v[1]); pk[2 * hf + 1] = pk2(v[2], v[3]); }
                const u32x4 u = {pk[0], pk[1], pk[2], pk[3]};
                mfrag[ks] = __builtin_bit_cast(bf16x8, u);
            }
        }
        __syncthreads();
        if (hh > 0) {
#pragma unroll
            for (int i = 0; i < 2; ++i) { const int ch = tid + NTHR * i, row = ch >> 3, c8 = ch & 7; const u32x4 yv = *(const LAS u32x4*)(SSD4_ZS(nb_) + row * 72 + c8 * 8);
                *(u32x4*)(P + (size_t)(t0 + row) * LDP + PZS + (head - 1) * 64 + c8 * 8) = yv; }
        }
        if (hh < 7) { if (nb_) SSD4_STAGE(1); else SSD4_STAGE(0); if (hh < 6) SSD4_LOAD(head + 2); }
        f32x4 ya[4][1];
#pragma unroll
        for (int mt = 0; mt < 4; ++mt) ya[mt][0] = (f32x4){0.f, 0.f, 0.f, 0.f};
        mma_lds<4, 1, 4>(ya, HP, LP, CM + wave * 16 * LP, LP, lane);
        { const float ea = __expf(s_ac[hh * 128 + lcol]);
#pragma unroll
          for (int mt = 0; mt < 4; ++mt) ya[mt][0] *= ea; }
#pragma unroll
        for (int ks = 0; ks < 4; ++ks) {
#pragma unroll
            for (int mt = 0; mt < 4; ++mt) {
                const LAS u16* p0 = XS + (32 * ks + 4 * q + (r >> 2)) * 72 + 16 * mt + (r & 3) * 4;
                const v4i16_t lo = __builtin_amdgcn_ds_read_tr16_b64_v4i16((LAS v4i16_t*)p0);
                const v4i16_t hi = __builtin_amdgcn_ds_read_tr16_b64_v4i16((LAS v4i16_t*)(p0 + 16 * 72));
                const bf16x8 af = __builtin_shufflevector(lo, hi, 0, 1, 2, 3, 4, 5, 6, 7);
                ya[mt][0] = __builtin_amdgcn_mfma_f32_16x16x32_bf16(af, mfrag[ks], ya[mt][0], 0, 0, 0);
            }
        }
        const float dsk = s_rs[128 + hh];
        {
            u32x2 xs4[4], zs4[4];
#pragma unroll
            for (int mt = 0; mt < 4; ++mt) { xs4[mt] = *(const LAS u32x2*)(XS + lcol * 72 + 16 * mt + 4 * q); zs4[mt] = *(const LAS u32x2*)(ZS + lcol * 72 + 16 * mt + 4 * q); }
#pragma unroll
            for (int mt = 0; mt < 4; ++mt) {
                const float xf[4] = {bflo(xs4[mt].x), bfhi(xs4[mt].x), bflo(xs4[mt].y), bfhi(xs4[mt].y)};
                const float zf[4] = {bflo(zs4[mt].x), bfhi(zs4[mt].x), bflo(zs4[mt].y), bfhi(zs4[mt].y)};
                float y[4];
#pragma unroll
                for (int i = 0; i < 4; ++i) { y[i] = (ya[mt][0][i] + dsk * xf[i]) * zf[i]; ssq += y[i] * y[i]; }
                u32x2 o; o.x = pk2(y[0], y[1]); o.y = pk2(y[2], y[3]);
                *(LAS u32x2*)(ZS + lcol * 72 + 16 * mt + 4 * q) = o;
            }
        }
    }
#undef SSD4_LOAD
    ssq += __shfl_xor(ssq, 16); ssq += __shfl_xor(ssq, 32);
    if (q == 0) ((float*)(p.ws + WS_RSG))[2 * (size_t)(t0 + lcol) + g] = rsqrtf(ssq * (1.f / 512.f) + EPS);
    __syncthreads();
#pragma unroll
    for (int i = 0; i < 2; ++i) { const int ch = tid + NTHR * i, row = ch >> 3, c8 = ch & 7; const u32x4 yv = *(const LAS u32x4*)(SSD4_ZS(1) + row * 72 + c8 * 8);
        *(u32x4*)(P + (size_t)(t0 + row) * LDP + PZS + (g * 8 + 7) * 64 + c8 * 8) = yv; }
    __syncthreads();
#undef SSD4_STAGE
#undef SSD4_XS
#undef SSD4_ZS
#undef SSD4_HP
}

__device__ __forceinline__ void phase6(const Params& p) {
    const int lane = threadIdx.x & 63, wave = threadIdx.x >> 6;
    const int gw = blockIdx.x * 8 + wave, NGW = gridDim.x * 8;
    const u16* Z = (const u16*)(p.ws + WS_H);
    f32x4 nw[4];
#pragma unroll
    for (int j = 0; j < 4; ++j) nw[j] = ((const f32x4*)p.fnw)[lane + 64 * j];
    for (int r4 = gw; r4 < T / 4; r4 += NGW) {
        u32x2 zv[4][4]; float s[4]; f32x4 f[4][4];
#pragma unroll
        for (int k = 0; k < 4; ++k)
#pragma unroll
            for (int j = 0; j < 4; ++j) { zv[k][j] = ((const u32x2*)(Z + (size_t)(4 * r4 + k) * DM))[lane + 64 * j]; f[k][j] = __builtin_nontemporal_load((const f32x4*)(p.x + (size_t)(4 * r4 + k) * DM) + lane + 64 * j); }
#pragma unroll
        for (int k = 0; k < 4; ++k) { s[k] = 0.f;
#pragma unroll
            for (int j = 0; j < 4; ++j) { f[k][j] += (f32x4){bflo(zv[k][j].x), bfhi(zv[k][j].x), bflo(zv[k][j].y), bfhi(zv[k][j].y)};
                s[k] += (f[k][j].x * f[k][j].x + f[k][j].y * f[k][j].y) + (f[k][j].z * f[k][j].z + f[k][j].w * f[k][j].w); } }
#pragma unroll
        for (int o = 1; o < 64; o <<= 1) {
#pragma unroll
            for (int k = 0; k < 4; ++k) s[k] += __shfl_xor(s[k], o); }
#pragma unroll
        for (int k = 0; k < 4; ++k) { const float rstd = rsqrtf(s[k] * (1.f / DM) + EPS);
#pragma unroll
            for (int j = 0; j < 4; ++j) ((f32x4*)(p.out + (size_t)(4 * r4 + k) * DM))[lane + 64 * j] = f[k][j] * rstd * nw[j]; }
    }
}

__global__ void __launch_bounds__(NTHR) fwd_kernel(Params p) {
    extern __shared__ __attribute__((aligned(16))) unsigned char lds_raw[];
    LAS unsigned char* lds = (LAS unsigned char*)lds_raw;
    cg::grid_group grid = cg::this_grid();
    const int lo = p.ph_lo, hi = p.ph_hi;
    if (lo < 0) grid.sync();
    volatile LAS unsigned* xbst = (volatile LAS unsigned*)(lds + LDS_BYTES - 16);
    if (threadIdx.x < 4) xbst[threadIdx.x] = 0u;
    __syncthreads();
    XcdBarrier bar = xcd_barrier_post((unsigned*)(p.ws + WS_BAR), xbst);
#ifndef PHMASK
#define PHMASK 127
#endif
#define IN(k) (((PHMASK >> (k)) & 1) && lo <= (k) && (k) < hi)
#define SEAM(k) do { if (IN(k) && IN((k) + 1)) xcd_barrier(bar); } while (0)
#ifndef PROBE
#define PROBE 0
#endif
#define GSYNC() do { if (hi - lo > 1) xcd_barrier(bar); } while (0)
#define PH1() do { pg8::Gemm g{(const u16*)(p.ws + WS_H), (const u16*)(p.ws + WS_WTIN), T, LDP, DM, DM}; pg8::StaticOrder S; S.init(T, LDP, gridDim.x, blockIdx.x); \
        pg8::EpiP E{(u16*)(p.ws + WS_P), LDP, nullptr}; pg8::gemm_phase<pg8::EpiP, pg8::StaticOrder>(lds, g, S, E); } while (0)
#define PH2() do { { M2Pre pre_; if ((int)blockIdx.x < 1024) m2_load(p, blockIdx.x, pre_); for (int it = blockIdx.x; it < 1024; it += gridDim.x) { const int nx_ = it + gridDim.x; phase2_mlstm(p, lds, it, pre_, nx_ < 1024 ? nx_ : it); } } \
        for (int it = blockIdx.x; it < 512; it += gridDim.x) phase2_ssd(p, lds, it); } while (0)
#define PH4() do { { M4Pre pre_; if ((int)blockIdx.x < 1024) m4_load(p, blockIdx.x, pre_); for (int it = blockIdx.x; it < 1024; it += gridDim.x) { const int nx_ = it + gridDim.x; phase4_mlstm(p, lds, it, pre_, nx_ < 1024 ? nx_ : it, it == (int)blockIdx.x || (gridDim.x & 3) != 0); } } \
        for (int it = blockIdx.x; it < 512; it += gridDim.x) phase4_ssd(p, lds, it); } while (0)
#define PH5() do { pg8::Gemm g{(const u16*)(p.ws + WS_P) + PO, (const u16*)(p.ws + WS_WTOUT), T, DM, 2048, LDP}; pg8::StaticOrder S; S.init(T, DM, gridDim.x, blockIdx.x); \
        pg8::EpiOut E{(u16*)(p.ws + WS_H), p.x, DM, (const float*)(p.ws + WS_RSG)}; pg8::gemm_phase<pg8::EpiOut, pg8::StaticOrder>(lds, g, S, E); } while (0)
    if (IN(0)) { phase0(p, lds); if (PROBE == 1) { GSYNC(); phase0(p, lds); } }
    SEAM(0);
    if (IN(1)) { PH1(); if (PROBE == 2) { GSYNC(); PH1(); } }
    SEAM(1);
    if (IN(2)) { PH2(); if (PROBE == 3) { GSYNC(); PH2(); } }
    SEAM(2);
    if (IN(3)) { phase3(p); if (PROBE == 4) { GSYNC(); PH2(); GSYNC(); phase3(p); } }
    SEAM(3);
    if (IN(4)) PH4();
    SEAM(4);
    if (IN(5)) { PH5(); if (PROBE == 6) { GSYNC(); PH5(); } }
    SEAM(5);
    if (IN(6)) { phase6(p); if (PROBE == 5) { GSYNC(); PH5(); GSYNC(); phase6(p); } }
#undef IN
#undef SEAM
}

extern "C" void kernel_launch(void* const* d_in, const int* in_sizes, int n_in, void* d_out, int out_size, void* d_ws, size_t ws_size, hipStream_t stream) {
    static int grid = 0;
    if (grid == 0) {
        if (n_in != 14 || out_size != T * DM || ws_size < WS_END) { fprintf(stderr, "kernel_launch: unexpected sizes n_in %d out %d ws %zu (need %zu)\n", n_in, out_size, ws_size, (size_t)WS_END); grid = -1; return; }
        int dev = 0, cus = 0;
        hipGetDevice(&dev); hipDeviceGetAttribute(&cus, hipDeviceAttributeMultiprocessorCount, dev);
        if (hipFuncSetAttribute((const void*)fwd_kernel, hipFuncAttributeMaxDynamicSharedMemorySize, LDS_BYTES) != hipSuccess) { fprintf(stderr, "kernel_launch: hipFuncSetAttribute failed\n"); grid = -1; return; }
        int per_cu = 0;
        if (hipOccupancyMaxActiveBlocksPerMultiprocessor(&per_cu, (const void*)fwd_kernel, NTHR, LDS_BYTES) != hipSuccess || per_cu < 1) { fprintf(stderr, "kernel_launch: occupancy query says %d\n", per_cu); }
        (void)hipGetLastError();
        grid = cus > 0 ? cus : 256;
    }
    if (grid < 0) return;
    Params p{};
    p.x = (const float*)d_in[0]; p.norm_w = (const float*)d_in[1]; p.w_in = (const float*)d_in[2]; p.b_i = (const float*)d_in[3]; p.b_f = (const float*)d_in[4];
    p.conv_w = (const float*)d_in[5]; p.conv_b = (const float*)d_in[6]; p.dt_bias = (const float*)d_in[7]; p.a_log = (const float*)d_in[8]; p.d_skip = (const float*)d_in[9];
    p.mnw = (const float*)d_in[10]; p.snw = (const float*)d_in[11]; p.w_out = (const float*)d_in[12]; p.fnw = (const float*)d_in[13];
    p.out = (float*)d_out; p.ws = (unsigned char*)d_ws;
    (void)hipMemsetAsync((char*)d_ws + WS_BAR, 0, 16384, stream);
#if ONE_LAUNCH
    p.ph_lo = 0; p.ph_hi = 7;
    void* args[] = {&p};
    hipError_t e = hipLaunchCooperativeKernel((const void*)fwd_kernel, dim3(grid), dim3(NTHR), args, LDS_BYTES, stream);
    if (e != hipSuccess) fprintf(stderr, "cooperative launch failed: %s (grid %d)\n", hipGetErrorString(e), grid);
#else
    for (int ph = 0; ph < 7; ++ph) { p.ph_lo = ph; p.ph_hi = ph + 1; hipLaunchKernelGGL(fwd_kernel, dim3(grid), dim3(NTHR), LDS_BYTES, stream, p); }
#endif
}
```

```cpp
#include <hip/hip_runtime.h>
#include <hip/hip_cooperative_groups.h>
#include <cstdio>
namespace cg = cooperative_groups;

#define LAS __attribute__((address_space(3)))
typedef unsigned short u16;
typedef short bf16x8 __attribute__((ext_vector_type(8)));
typedef float f32x4 __attribute__((ext_vector_type(4)));
typedef float f32x2 __attribute__((ext_vector_type(2)));
typedef unsigned u32x4 __attribute__((ext_vector_type(4)));
typedef unsigned u32x2 __attribute__((ext_vector_type(2)));
typedef __bf16 bf16x2_t __attribute__((ext_vector_type(2)));

#ifndef ONE_LAUNCH
#define ONE_LAUNCH 1
#endif

constexpr int T = 32768, DM = 1024, SEQ = 8192, NCH = 64, CL = 128;
constexpr int DIN = 6680;
constexpr int LDP = 6656;
constexpr int PQ = 0, PK = 512, PV = 1024, PZM = 2048, PO = 3072, PZS = 4096, PX = 5120, PBM = 6144, PCM = 6400;
constexpr int NGT = 32;
constexpr float EPS = 1e-6f, CAP = 15.0f;
constexpr int NTHR = 512;
constexpr int LDS_BYTES = 163840;

constexpr size_t WS_WTIN = 0;
constexpr size_t WS_WTOUT = WS_WTIN + (size_t)LDP * DM * 2;
constexpr size_t WS_G = WS_WTOUT + (size_t)1024 * 2048 * 2;
constexpr size_t WS_NLOC = WS_G + (size_t)T * NGT * 4;
constexpr size_t WS_MBL = WS_NLOC + (size_t)1024 * 128 * 4;
constexpr size_t WS_MGM = WS_MBL + 4096;
constexpr size_t WS_MPREV = WS_MGM + 4096;
constexpr size_t WS_SDEC = WS_MPREV + 4096;
constexpr size_t WS_BAR = WS_SDEC + 16384;
constexpr size_t WS_RSG = WS_BAR + 16384;
constexpr size_t WS_LU = WS_RSG + (size_t)T * 2 * 4;
constexpr size_t WS_LB = WS_LU + (size_t)1024 * 128 * 4;
constexpr size_t WS_SG = WS_LB + (size_t)1024 * 128 * 4;
constexpr size_t WS_H = WS_SG + (size_t)512 * 2048 * 4;
constexpr size_t WS_P = WS_H + (size_t)T * DM * 2;
constexpr size_t WS_END = WS_P + (size_t)T * LDP * 2;

struct Params {
    const float *x, *norm_w, *w_in, *b_i, *b_f, *conv_w, *conv_b, *dt_bias, *a_log, *d_skip, *mnw, *snw, *w_out, *fnw;
    float* out; unsigned char* ws; int ph_lo, ph_hi;
};

__device__ __forceinline__ unsigned pk2(float lo, float hi) { f32x2 v = {lo, hi}; bf16x2_t b = __builtin_convertvector(v, bf16x2_t); return __builtin_bit_cast(unsigned, b); }
__device__ __forceinline__ u16 f2bf(float f) { return (u16)(pk2(f, 0.f) & 0xffffu); }
__device__ __forceinline__ float bf2f(u16 b) { return __uint_as_float((unsigned)b << 16); }
__device__ __forceinline__ float bflo(unsigned u) { return __uint_as_float(u << 16); }
__device__ __forceinline__ float bfhi(unsigned u) { return __uint_as_float(u & 0xffff0000u); }
__device__ __forceinline__ void unpack8(const u32x4 v, float* f) {
    f[0] = bflo(v.x); f[1] = bfhi(v.x); f[2] = bflo(v.y); f[3] = bfhi(v.y); f[4] = bflo(v.z); f[5] = bfhi(v.z); f[6] = bflo(v.w); f[7] = bfhi(v.w);
}
__device__ __forceinline__ float wave_sum(float v) {
#pragma unroll
    for (int o = 1; o < 64; o <<= 1) v += __shfl_xor(v, o);
    return v;
}
__device__ __forceinline__ float siluf(float v) { return v * __builtin_amdgcn_rcpf(1.f + __expf(-v)); }
__device__ __forceinline__ float sigmf(float v) { return __builtin_amdgcn_rcpf(1.f + __expf(-v)); }
__device__ __forceinline__ float softplusf(float v) { return fmaxf(v, 0.f) + log1pf(expf(-fabsf(v))); }
__device__ __forceinline__ float softcap(float v) { return CAP * tanhf(v * (1.0f / CAP)); }
#define LDS_WAIT() asm volatile("s_waitcnt lgkmcnt(0)" ::: "memory")

template <int MT, int NT, int KS>
__device__ __forceinline__ void mma_lds(f32x4 (&acc)[MT][NT], const LAS u16* A, int lda, const LAS u16* B, int ldb, int lane) {
    const int r = lane & 15, q = lane >> 4;
#pragma unroll
    for (int ks = 0; ks < KS; ++ks) {
        asm volatile("" ::: "memory");
        bf16x8 a[MT], b[NT];
#pragma unroll
        for (int m = 0; m < MT; ++m) a[m] = *(const LAS bf16x8*)(A + (m * 16 + r) * lda + ks * 32 + q * 8);
#pragma unroll
        for (int n = 0; n < NT; ++n) b[n] = *(const LAS bf16x8*)(B + (n * 16 + r) * ldb + ks * 32 + q * 8);
#pragma unroll
        for (int m = 0; m < MT; ++m)
#pragma unroll
            for (int n = 0; n < NT; ++n) acc[m][n] = __builtin_amdgcn_mfma_f32_16x16x32_bf16(a[m], b[n], acc[m][n], 0, 0, 0);
    }
}


typedef short v4i16_t __attribute__((ext_vector_type(4)));
__device__ __forceinline__ bf16x8 frag_tr(const LAS u16* X, int ld, int k0, int n0, int lane) {
    const int g = lane >> 4, a = lane & 15;
    const LAS u16* p0 = X + (k0 + 8 * g + (a >> 2)) * ld + n0 + (a & 3) * 4;
    const v4i16_t lo = __builtin_amdgcn_ds_read_tr16_b64_v4i16((LAS v4i16_t*)p0);
    const v4i16_t hi = __builtin_amdgcn_ds_read_tr16_b64_v4i16((LAS v4i16_t*)(p0 + 4 * ld));
    return __builtin_shufflevector(lo, hi, 0, 1, 2, 3, 4, 5, 6, 7);
}
template <int MT, int NT, int KS>
__device__ __forceinline__ void mma_lds_bt(f32x4 (&acc)[MT][NT], const LAS u16* A, int lda, const LAS u16* B, int ldb, int lane) {
    const int r = lane & 15, q = lane >> 4;
#pragma unroll
    for (int ks = 0; ks < KS; ++ks) {
        asm volatile("" ::: "memory");
        bf16x8 a[MT], b[NT];
#pragma unroll
        for (int m = 0; m < MT; ++m) a[m] = *(const LAS bf16x8*)(A + (m * 16 + r) * lda + ks * 32 + q * 8);
#pragma unroll
        for (int n = 0; n < NT; ++n) b[n] = frag_tr(B, ldb, ks * 32, n * 16, lane);
#pragma unroll
        for (int m = 0; m < MT; ++m)
#pragma unroll
            for (int n = 0; n < NT; ++n) acc[m][n] = __builtin_amdgcn_mfma_f32_16x16x32_bf16(a[m], b[n], acc[m][n], 0, 0, 0);
    }
}
template <int MT, int NT, int KS>
__device__ __forceinline__ void mma_lds_tt(f32x4 (&acc)[MT][NT], const LAS u16* A, int lda, const LAS u16* B, int ldb, int lane) {
#pragma unroll
    for (int ks = 0; ks < KS; ++ks) {
        asm volatile("" ::: "memory");
        bf16x8 a[MT], b[NT];
#pragma unroll
        for (int m = 0; m < MT; ++m) a[m] = frag_tr(A, lda, ks * 32, m * 16, lane);
#pragma unroll
        for (int n = 0; n < NT; ++n) b[n] = frag_tr(B, ldb, ks * 32, n * 16, lane);
#pragma unroll
        for (int m = 0; m < MT; ++m)
#pragma unroll
            for (int n = 0; n < NT; ++n) acc[m][n] = __builtin_amdgcn_mfma_f32_16x16x32_bf16(a[m], b[n], acc[m][n], 0, 0, 0);
    }
}

namespace pg8 {
constexpr int BM = 256, BK = 64, HALF = 128, HTB = HALF * BK * 2, STAGE_BYTES = 8 * HTB, NXCD = 8, WGM = 8;
__device__ __forceinline__ int lds_byte(int r, int c) { const int st = (r >> 4) * 2 + (c >> 5), rr = r & 15, cc = c & 31, ob = rr * 64 + cc * 2; return st * 1024 + (ob ^ (((ob >> 9) & 1) << 5)); }
__device__ __forceinline__ void stage_rc(int b, int& R, int& C) { const int st = b / 1024, sb = b % 1024, swz = sb ^ (((sb >> 9) & 1) << 5); R = (st >> 1) * 16 + swz / 64; C = (st & 1) * 32 + (swz % 64) / 2; }
__device__ __forceinline__ int perm32(int rho) { const int n = rho >> 4, i = rho & 15; return 8 * (i >> 2) + 4 * n + (i & 3); }
struct Unit { int pm, pn; };
struct Gemm { const u16* A; const u16* Bt; int M, N, K, lda; };
struct StaticOrder {
    int nM, nN, nwg, G, c;
    __device__ void init(int M, int N, int G_, int c_) { nM = M / BM; nN = N / BM; nwg = nM * nN; G = G_; c = c_; }
    __device__ bool next(int i, Unit& u) const {
        const long Lx = (long)i * G + c; if (Lx >= nwg) return false;
        int wgid = (int)Lx; { const int q = nwg / NXCD, r = nwg % NXCD, xcd = wgid % NXCD, off = wgid / NXCD; wgid = (xcd < r ? xcd * (q + 1) : r * (q + 1) + (xcd - r) * q) + off; }
        const int nig = WGM * nN, gid = wgid / nig, fm = gid * WGM, gsz = (nM - fm) < WGM ? (nM - fm) : WGM;
        u.pm = fm + ((wgid % nig) % gsz); u.pn = (wgid % nig) / gsz; return true;
    }
};
struct EpiP {
    static constexpr bool PERM = true, HORNER = false;
    u16* O; int ldc; const float* rsg;
    __device__ __forceinline__ void operator()(const f32x4 (&acc)[2][2][4][2], const Unit& u, int wr, int wc, int fr, int fq) const {
        const int row0 = u.pm * BM + wr * 64 + fr; const int col0 = u.pn * BM + wc * 32 + 8 * fq;
        if (u.pn >= 8 && u.pn < 16) {
            const int gcol = 2048 + 128 * (u.pn - 8) + wc * 32 + 8 * fq;
#pragma unroll
            for (int ai = 0; ai < 2; ++ai)
#pragma unroll
                for (int m = 0; m < 4; ++m) { u16* rowp = O + (size_t)(row0 + ai * HALF + m * 16) * ldc + gcol;
                    float gt[8];
#pragma unroll
                    for (int n = 0; n < 2; ++n)
#pragma unroll
                        for (int i = 0; i < 4; ++i) { const float zo = acc[ai][1][m][n][i]; gt[n * 4 + i] = zo * __builtin_amdgcn_rcpf((1.f + __expf(-acc[ai][0][m][n][i])) * (1.f + __expf(-zo))); }
                    u32x4 w; w.x = pk2(gt[0], gt[1]); w.y = pk2(gt[2], gt[3]); w.z = pk2(gt[4], gt[5]); w.w = pk2(gt[6], gt[7]);
                    __builtin_nontemporal_store(w, (u32x4*)rowp); }
            return;
        }
        const bool zs_tile = u.pn >= 16 && u.pn < 20;
        const bool lo = fr < 8; const int colb = u.pn * BM + wc * 64 + 8 * fq + (lo ? 0 : 32), rowb = u.pm * BM + wr * 64 + (fr & 7);
#pragma unroll
        for (int ai = 0; ai < 2; ++ai)
#pragma unroll
            for (int m = 0; m < 4; ++m) {
                u32x4 xy[2];
#pragma unroll
                for (int bj = 0; bj < 2; ++bj) { f32x4 v0 = acc[ai][bj][m][0], v1 = acc[ai][bj][m][1];
                    if (zs_tile) {
#pragma unroll
                        for (int i = 0; i < 4; ++i) { v0[i] = siluf(v0[i]); v1[i] = siluf(v1[i]); } }
                    xy[bj].x = pk2(v0[0], v0[1]); xy[bj].y = pk2(v0[2], v0[3]); xy[bj].z = pk2(v1[0], v1[1]); xy[bj].w = pk2(v1[2], v1[3]); }
                const u32x4 snd = lo ? xy[1] : xy[0]; u32x4 rcv;
                rcv.x = (unsigned)__shfl_xor((int)snd.x, 8); rcv.y = (unsigned)__shfl_xor((int)snd.y, 8); rcv.z = (unsigned)__shfl_xor((int)snd.z, 8); rcv.w = (unsigned)__shfl_xor((int)snd.w, 8);
                const u32x4 dA = lo ? xy[0] : rcv, dB = lo ? rcv : xy[1];
                u16* rp = O + (size_t)(rowb + ai * HALF + m * 16) * ldc + colb;
                __builtin_nontemporal_store(dA, (u32x4*)rp);
                __builtin_nontemporal_store(dB, (u32x4*)(rp + (size_t)8 * ldc)); }
    }
};
struct EpiOut {
    static constexpr bool PERM = false, HORNER = true;
    u16* Z; const float* res; int ldc; const float* rsg;
    __device__ __forceinline__ void operator()(const f32x4 (&acc)[2][2][4][2], const Unit& u, int wr, int wc, int fr, int fq, const LAS unsigned char* fac) const {
        const int row0 = u.pm * BM + wr * 64 + fr, col0 = u.pn * BM + wc * 32 + 4 * fq;
#pragma unroll
        for (int ai = 0; ai < 2; ++ai)
#pragma unroll
            for (int m = 0; m < 4; ++m) { const size_t off = (size_t)(row0 + ai * HALF + m * 16) * ldc + col0;
                const float r1 = ((const LAS float*)fac)[2 * (ai * HALF + wr * 64 + m * 16 + fr) + 1];
#pragma unroll
                for (int bj = 0; bj < 2; ++bj)
#pragma unroll
                    for (int n = 0; n < 2; ++n) { const f32x4 z = acc[ai][bj][m][n] * r1; u32x2 o; o.x = pk2(z[0], z[1]); o.y = pk2(z[2], z[3]); *(u32x2*)(Z + off + bj * HALF + n * 16) = o; } }
    }
};

template <class Epi, class Sched>
__device__ __forceinline__ void gemm_phase(LAS unsigned char* lds, const Gemm g, const Sched& S, const Epi& E) {
    const int tid = threadIdx.x, wid = __builtin_amdgcn_readfirstlane(tid >> 6), lane = tid & 63, wr = wid >> 2, wc = wid & 3, fr = lane & 15, fq = lane >> 4;
    const int K = g.K, nt = K / BK, lda = g.lda;
    unsigned voffA[2], voffB[2];
#pragma unroll
    for (int i = 0; i < 2; ++i) { int R, C; stage_rc(tid * 16 + i * 8192, R, C); const int Rb = Epi::PERM ? ((R >> 5) * 64 + perm32(R & 31)) : R;
        voffA[i] = (unsigned)(R * lda + C) * 2u; voffB[i] = (unsigned)(Rb * K + C) * 2u; }
    const size_t kstep = (size_t)(BK * 2);
    const size_t hstepA = (size_t)HALF * lda * 2, hstepB = (size_t)(Epi::PERM ? 32 : HALF) * K * 2;
    const size_t tstepA = 2 * hstepA, tstepB = (size_t)BM * K * 2;
    const unsigned ldsw = (unsigned)wid * 1024u;
    const int aoff = lds_byte(wr * 64 + fr, fq * 8), boff = lds_byte(wc * 32 + fr, fq * 8);
#define PG8_SA(b, h) (((b) * 2 + (h)) * HTB)
#define PG8_SB(b, h) ((4 + (b) * 2 + (h)) * HTB)
#define PG8_STAGE(bufoff, gbase, voff) do { _Pragma("unroll") for (int _i = 0; _i < 2; ++_i) \
        __builtin_amdgcn_global_load_lds((const unsigned*)((const char*)(gbase) + (voff)[_i]), (LAS unsigned*)(lds + (bufoff) + ldsw + _i * 8192), 16, 0, 0); } while (0)
#define PG8_LDA(dst, b, h) do { _Pragma("unroll") for (int m = 0; m < 4; ++m) _Pragma("unroll") for (int k = 0; k < 2; ++k) dst[m][k] = *(const LAS bf16x8*)(lds + PG8_SA(b, h) + aoff + m * 2048 + k * 1024); } while (0)
#define PG8_LDB(dst, b, h) do { _Pragma("unroll") for (int n = 0; n < 2; ++n) _Pragma("unroll") for (int k = 0; k < 2; ++k) dst[n][k] = *(const LAS bf16x8*)(lds + PG8_SB(b, h) + boff + n * 2048 + k * 1024); } while (0)
#define PG8_MMA(ai, bj, At, Bt) do { __builtin_amdgcn_s_setprio(1); _Pragma("unroll") for (int m = 0; m < 4; ++m) _Pragma("unroll") for (int n = 0; n < 2; ++n) _Pragma("unroll") for (int k = 0; k < 2; ++k) \
        acc[ai][bj][m][n] = __builtin_amdgcn_mfma_f32_16x16x32_bf16(Bt[n][k], At[m][k], acc[ai][bj][m][n], 0, 0, 0); __builtin_amdgcn_s_setprio(0); } while (0)
#define PG8_WAIT_V(n) asm volatile("s_waitcnt vmcnt(" #n ")" ::: "memory")
#define PG8_WAIT_L(n) asm volatile("s_waitcnt lgkmcnt(" #n ")" ::: "memory")
#define PG8_BAR __builtin_amdgcn_s_barrier()
#define PG8_SCHED __builtin_amdgcn_sched_barrier(0)
    Unit cur, nxt; int ui = 0;
    if (!S.next(0, cur)) return;
    f32x4 acc[2][2][4][2];
#pragma unroll
    for (int a = 0; a < 2; ++a)
#pragma unroll
        for (int b = 0; b < 2; ++b)
#pragma unroll
            for (int m = 0; m < 4; ++m)
#pragma unroll
                for (int n = 0; n < 2; ++n) acc[a][b][m][n] = (f32x4){0.f, 0.f, 0.f, 0.f};
    bf16x8 At[4][2], B0[2][2], B1[2][2];
    const char* cA = (const char*)g.A + (size_t)cur.pm * tstepA; const char* cB = (const char*)g.Bt + (size_t)cur.pn * tstepB;
#define PG8_AK(t_) ((size_t)(t_) * kstep)
#define PG8_HLOAD(u_) do { if constexpr (Epi::HORNER) { __builtin_amdgcn_global_load_lds((const unsigned*)(E.rsg + 2 * (size_t)(u_).pm * BM + tid), (LAS unsigned*)(lds + STAGE_BYTES + (ui & 1) * 2048 + wid * 256), 4, 0, 0); } } while (0)
#define PG8_HSCALE(second_) do { _Pragma("unroll") for (int ai = 0; ai < 2; ++ai) _Pragma("unroll") for (int m = 0; m < 4; ++m) { asm volatile("" ::: "memory"); \
        const f32x2 rr_ = *(const LAS f32x2*)(lds + STAGE_BYTES + (ui & 1) * 2048 + 8 * (ai * HALF + wr * 64 + m * 16 + fr)); const float hf_ = (second_) ? rr_.x * __builtin_amdgcn_rcpf(rr_.y) : __builtin_amdgcn_rcpf(rr_.x); \
        _Pragma("unroll") for (int bj = 0; bj < 2; ++bj) _Pragma("unroll") for (int n = 0; n < 2; ++n) acc[ai][bj][m][n] *= hf_; } } while (0)
    PG8_HLOAD(cur);
    PG8_STAGE(PG8_SB(0, 0), cB, voffB); PG8_STAGE(PG8_SA(0, 0), cA + PG8_AK(0), voffA); PG8_STAGE(PG8_SB(0, 1), cB + hstepB, voffB); PG8_STAGE(PG8_SA(0, 1), cA + PG8_AK(0) + hstepA, voffA);
    if (wr == 1) PG8_BAR;
    PG8_WAIT_V(4); PG8_BAR;
    PG8_STAGE(PG8_SB(1, 0), cB + kstep, voffB); PG8_STAGE(PG8_SA(1, 0), cA + PG8_AK(1), voffA); PG8_STAGE(PG8_SB(1, 1), cB + hstepB + kstep, voffB);
    PG8_WAIT_V(6); PG8_BAR;
    for (;;) {
        const bool has_next = S.next(ui + 1, nxt);
        const char* nA = has_next ? (const char*)g.A + (size_t)nxt.pm * tstepA : cA; const char* nB = has_next ? (const char*)g.Bt + (size_t)nxt.pn * tstepB : cB;
#pragma unroll 1
        for (int seg = 0; seg < (Epi::HORNER ? 3 : 1); ++seg) {
        const int tb = Epi::HORNER ? (seg == 0 ? 0 : (seg == 1 ? 16 : 24)) : 0, te = Epi::HORNER ? (seg == 0 ? 16 : (seg == 1 ? 24 : nt)) : nt;
        if constexpr (Epi::HORNER) { if (seg > 0) PG8_HSCALE(seg == 2); }
#pragma unroll 1
        for (int t = tb; t < te; t += 2) {
            const bool last = (t == nt - 2);
            const char* a1 = cA + PG8_AK(t + 1);
            const char* a2 = last ? nA + PG8_AK(0) : cA + PG8_AK(t + 2); const char* b2 = last ? nB : cB + (size_t)(t + 2) * kstep;
            const char* a3 = last ? nA + PG8_AK(1) : cA + PG8_AK(t + 3); const char* b3 = b2 + kstep;
            PG8_LDB(B0, 0, 0); PG8_SCHED; PG8_LDA(At, 0, 0); PG8_STAGE(PG8_SA(1, 1), a1 + hstepA, voffA);
            PG8_WAIT_L(8); PG8_BAR; PG8_WAIT_L(0); PG8_MMA(0, 0, At, B0); PG8_BAR; PG8_SCHED;
            PG8_LDB(B1, 0, 1); PG8_STAGE(PG8_SB(0, 0), b2, voffB);
            PG8_BAR; PG8_WAIT_L(0); PG8_MMA(0, 1, At, B1); PG8_BAR;
            PG8_LDA(At, 0, 1); PG8_STAGE(PG8_SA(0, 0), a2, voffA);
            PG8_BAR; PG8_WAIT_L(0); PG8_MMA(1, 0, At, B0); PG8_BAR; PG8_SCHED;
            PG8_STAGE(PG8_SB(0, 1), b2 + hstepB, voffB);
            PG8_WAIT_V(6); PG8_BAR; PG8_MMA(1, 1, At, B1); PG8_BAR;
            PG8_LDB(B0, 1, 0); PG8_SCHED; PG8_LDA(At, 1, 0); PG8_STAGE(PG8_SA(0, 1), a2 + hstepA, voffA);
            PG8_WAIT_L(8); PG8_BAR; PG8_WAIT_L(0); PG8_MMA(0, 0, At, B0); PG8_BAR; PG8_SCHED;
            PG8_LDB(B1, 1, 1); PG8_STAGE(PG8_SB(1, 0), b3, voffB);
            PG8_BAR; PG8_WAIT_L(0); PG8_MMA(0, 1, At, B1); PG8_BAR;
            PG8_LDA(At, 1, 1); PG8_STAGE(PG8_SA(1, 0), a3, voffA);
            PG8_BAR; PG8_WAIT_L(0); PG8_MMA(1, 0, At, B0); PG8_BAR; PG8_SCHED;
            PG8_STAGE(PG8_SB(1, 1), b3 + hstepB, voffB);
            PG8_WAIT_V(6); PG8_BAR; PG8_MMA(1, 1, At, B1); PG8_BAR;
        }
        }
        if constexpr (Epi::HORNER) E(acc, cur, wr, wc, fr, fq, lds + STAGE_BYTES + (ui & 1) * 2048); else E(acc, cur, wr, wc, fr, fq);
        if (!has_next) break;
#pragma unroll
        for (int a = 0; a < 2; ++a)
#pragma unroll
            for (int b = 0; b < 2; ++b)
#pragma unroll
                for (int m = 0; m < 4; ++m)
#pragma unroll
                    for (int n = 0; n < 2; ++n) acc[a][b][m][n] = (f32x4){0.f, 0.f, 0.f, 0.f};
        cur = nxt; cA = nA; cB = nB; ++ui;
        PG8_HLOAD(cur);
    }
    PG8_WAIT_V(0);
    if (wr == 0) PG8_BAR;
    PG8_BAR;
#undef PG8_AK
#undef PG8_HLOAD
#undef PG8_HSCALE
#undef PG8_SA
#undef PG8_SB
#undef PG8_STAGE
#undef PG8_LDA
#undef PG8_LDB
#undef PG8_MMA
#undef PG8_WAIT_V
#undef PG8_WAIT_L
#undef PG8_BAR
#undef PG8_SCHED
}
}

#include <hip/hip_runtime.h>
#include <cstdio>

#define XB_TMO      128
#define XB_XCNT(j)  (256  + 64 * (j))
#define XB_XSUB(j)  (1280 + 64 * (j))
#define XB_XGEN(j)  (2304 + 64 * (j))
#define XB_TOP      3328
#define XB_TOPGEN   3392
#define XCD_BAR_WORDS 3456
#define XB_SPIN_CAP (1u << 18)

__device__ __forceinline__ unsigned xb_ld(unsigned* p)              { return __hip_atomic_load(p, __ATOMIC_RELAXED, __HIP_MEMORY_SCOPE_AGENT); }
__device__ __forceinline__ unsigned xb_add(unsigned* p, unsigned v) { return __hip_atomic_fetch_add(p, v, __ATOMIC_RELAXED, __HIP_MEMORY_SCOPE_AGENT); }
__device__ __forceinline__ unsigned xb_xcc_id() { return (unsigned)__builtin_amdgcn_s_getreg((3 << 11) | 20) & 0xFu; }
#define XB_SPIN(cond, bar) do { unsigned _sp = 0; while (cond) { __builtin_amdgcn_s_sleep(1); \
    if ((++_sp & 255u) == 0u) { if (xb_ld(&(bar)[XB_TMO])) break; if (_sp > XB_SPIN_CAP) { atomicAdd(&(bar)[XB_TMO], 1u); break; } } } } while (0)

struct XcdBarrier {
    unsigned* bar; unsigned x;
    volatile LAS unsigned* st;
};

__device__ __forceinline__ XcdBarrier xcd_barrier_post(unsigned* bar, volatile LAS unsigned* st) {
    XcdBarrier b; b.bar = bar; b.x = xb_xcc_id(); b.st = st;
    if (threadIdx.x == 0) (void)xb_add(&bar[XB_XCNT(b.x)], 1u);
    return b;
}
__device__ __forceinline__ void xcd_barrier_complete(unsigned* bar, unsigned x, unsigned& nloc, unsigned& nx) {
    const unsigned G = gridDim.x * gridDim.y * gridDim.z;
    unsigned sum, cnt, mine, sp = 0u;
    for (;;) {
        sum = 0u; cnt = 0u; mine = 0u;
#pragma unroll
        for (unsigned j = 0; j < 16; ++j) { const unsigned c = xb_ld(&bar[XB_XCNT(j)]); sum += c; cnt += (c > 0u) ? 1u : 0u; mine = (j == x) ? c : mine; }
        if (sum == G) break;
        __builtin_amdgcn_s_sleep(1);
        if ((++sp & 255u) == 0u) { if (xb_ld(&bar[XB_TMO])) break; if (sp > XB_SPIN_CAP) { atomicAdd(&bar[XB_TMO], 1u); break; } }
    }
    nloc = mine > 0u ? mine : 1u; nx = cnt > 0u ? cnt : 1u;
}

__device__ __forceinline__ void xcd_barrier(const XcdBarrier& b) {
    asm volatile("s_waitcnt vmcnt(0)" ::: "memory");
    __syncthreads();
    if (threadIdx.x == 0) {
        unsigned* bar = b.bar;
        __builtin_amdgcn_s_waitcnt(0);
        unsigned nloc = b.st[0], nx = b.st[1];
        if (nloc == 0u) { xcd_barrier_complete(bar, b.x, nloc, nx); b.st[0] = nloc; b.st[1] = nx; }
        const unsigned old = xb_add(&bar[XB_XSUB(b.x)], 1u);
        const unsigned gen = old / nloc;
        if (old + 1u == (gen + 1u) * nloc) {
            __builtin_amdgcn_fence(__ATOMIC_RELEASE, "agent");
            asm volatile("s_waitcnt vmcnt(0)" ::: "memory");
            const unsigned og = xb_add(&bar[XB_TOP], 1u);
            const unsigned tg = og / nx;
            if (og + 1u == (tg + 1u) * nx) xb_add(&bar[XB_TOPGEN], 1u);
            else XB_SPIN(xb_ld(&bar[XB_TOPGEN]) == tg, bar);
            __builtin_amdgcn_fence(__ATOMIC_ACQUIRE, "agent");
            xb_add(&bar[XB_XGEN(b.x)], 1u);
            asm volatile("s_waitcnt vmcnt(0)" ::: "memory");
        } else {
            XB_SPIN(xb_ld(&bar[XB_XGEN(b.x)]) == gen, bar);
            __builtin_amdgcn_fence(__ATOMIC_ACQUIRE, "agent");
            asm volatile("s_waitcnt vmcnt(0)" ::: "memory");
        }
    }
    __syncthreads();
}

__device__ __forceinline__ int src_col(int n) {
    if (n < 2048) return n;
    if (n < 4096) { const int cb = (n - 2048) >> 8, off = (n - 2048) & 255;
        const int w = off >> 6, hsel = (off >> 5) & 1; return (hsel ? 3080 : 2056) + 128 * cb + 32 * w; }
    if (n < 5120) return 4104 + (n - 4096);
    return 5128 + (n - 5120);
}
__device__ __forceinline__ void transpose_item(const float* W, int ldw, int K, int srccol, u16* WT, int dstrow, LAS float* scr, int k0, int lane, int k0src, const float* rs) {
#pragma unroll 8
    for (int i = 0; i < 32; ++i) { const int kk = 2 * i + (lane >> 5); float v = W[(size_t)(k0src + kk) * ldw + srccol + (lane & 31)]; if (rs) v *= rs[k0 + kk]; scr[kk * 33 + (lane & 31)] = v; }
    LDS_WAIT();
    const int c = lane & 7;
#pragma unroll
    for (int j = 0; j < 4; ++j) { const int n = (lane >> 3) + 8 * j; const LAS float* s = scr + (8 * c) * 33 + n;
        u32x4 o; o.x = pk2(s[0 * 33], s[1 * 33]); o.y = pk2(s[2 * 33], s[3 * 33]); o.z = pk2(s[4 * 33], s[5 * 33]); o.w = pk2(s[6 * 33], s[7 * 33]);
        *(u32x4*)(WT + (size_t)(dstrow + n) * K + k0 + 8 * c) = o; }
    LDS_WAIT();
}

__device__ __forceinline__ void phase0(const Params& p, LAS unsigned char* lds) {
    const int tid = threadIdx.x, lane = tid & 63, wave = tid >> 6;
    const int gw = blockIdx.x * 8 + wave, NGW = gridDim.x * 8;
    u16* WtIn = (u16*)(p.ws + WS_WTIN); u16* WtOut = (u16*)(p.ws + WS_WTOUT);
    {
        LAS float* scr = (LAS float*)(lds + wave * 16384);
        constexpr int I_IN = 16 * 208, I_OUT = 32 * 32;
        for (int it = gw; it < I_IN + I_OUT; it += NGW) {
            if (it < I_IN) { const int kb = it / 208, nb = it % 208; transpose_item(p.w_in, DIN, 1024, src_col(32 * nb), WtIn, 32 * nb, scr, 64 * kb, lane, 64 * kb, nullptr); }
            else { const int r = it - I_IN; const int kb = r / 32, nb = r % 32; transpose_item(p.w_out, 1024, 2048, 32 * nb, WtOut, 32 * nb, scr, 64 * kb, lane, 64 * kb, kb >= 16 ? p.snw - 1024 : nullptr); }
        }
    }
    __syncthreads();
    LAS float* wg = (LAS float*)lds;
    for (int idx = tid; idx < 1024 * 24; idx += NTHR) {
        const int k = idx / 24, gc = idx % 24; const int col = gc < 8 ? 2048 + gc : 6664 + (gc - 8);
        const float v = p.w_in[(size_t)k * DIN + col];
        const int ln = (k & 255) >> 2, e = k & 3, j = k >> 8, c4 = gc >> 2, cm = gc & 3;
        wg[((((j * 4 + e) * 6 + c4) * 64 + ln) << 2) + cm] = v;
    }
    __syncthreads();
    u16* H = (u16*)(p.ws + WS_H); float* G = (float*)(p.ws + WS_G);
    f32x4 nw[4];
#pragma unroll
    for (int j = 0; j < 4; ++j) nw[j] = ((const f32x4*)p.norm_w)[lane + 64 * j];
    f32x4 vn[2][4];
#pragma unroll
    for (int r = 0; r < 2; ++r)
#pragma unroll
        for (int j = 0; j < 4; ++j) vn[r][j] = __builtin_nontemporal_load((const f32x4*)(p.x + (size_t)(2 * gw + r) * DM) + lane + 64 * j);
    for (int pr = gw; pr < T / 2; pr += NGW) {
        f32x4 v[2][4];
#pragma unroll
        for (int r = 0; r < 2; ++r)
#pragma unroll
            for (int j = 0; j < 4; ++j) v[r][j] = vn[r][j];
        { const int prn = (pr + NGW < T / 2) ? pr + NGW : pr;
#pragma unroll
          for (int r = 0; r < 2; ++r)
#pragma unroll
            for (int j = 0; j < 4; ++j) vn[r][j] = __builtin_nontemporal_load((const f32x4*)(p.x + (size_t)(2 * prn + r) * DM) + lane + 64 * j); }
#pragma unroll
        for (int r = 0; r < 2; ++r) {
            float s = 0.f;
#pragma unroll
            for (int j = 0; j < 4; ++j) s += (v[r][j].x * v[r][j].x + v[r][j].y * v[r][j].y) + (v[r][j].z * v[r][j].z + v[r][j].w * v[r][j].w);
            const float rstd = rsqrtf(wave_sum(s) * (1.f / DM) + EPS);
            u32x2* o8 = (u32x2*)(H + (size_t)(2 * pr + r) * DM) + lane;
#pragma unroll
            for (int j = 0; j < 4; ++j) { v[r][j] = v[r][j] * rstd * nw[j]; u32x2 o; o.x = pk2(v[r][j].x, v[r][j].y); o.y = pk2(v[r][j].z, v[r][j].w); o8[64 * j] = o; }
        }
        f32x2 a2[2][12];
#pragma unroll
        for (int i = 0; i < 12; ++i) { a2[0][i] = (f32x2){0.f, 0.f}; a2[1][i] = (f32x2){0.f, 0.f}; }
#pragma unroll
        for (int j = 0; j < 4; ++j)
#pragma unroll
            for (int e = 0; e < 4; ++e) {
                asm volatile("" ::: "memory");
#pragma unroll
                for (int c4 = 0; c4 < 6; ++c4) {
                    const f32x4 w = *(const LAS f32x4*)(wg + ((((j * 4 + e) * 6 + c4) * 64 + lane) << 2));
                    const f32x2 wlo = {w.x, w.y}, whi = {w.z, w.w};
                    const f32x2 h0 = {v[0][j][e], v[0][j][e]}, h1 = {v[1][j][e], v[1][j][e]};
                    a2[0][c4 * 2] = __builtin_elementwise_fma(h0, wlo, a2[0][c4 * 2]); a2[0][c4 * 2 + 1] = __builtin_elementwise_fma(h0, whi, a2[0][c4 * 2 + 1]);
                    a2[1][c4 * 2] = __builtin_elementwise_fma(h1, wlo, a2[1][c4 * 2]); a2[1][c4 * 2 + 1] = __builtin_elementwise_fma(h1, whi, a2[1][c4 * 2 + 1]);
                } }
        float a[48];
#pragma unroll
        for (int i = 0; i < 24; ++i) { a[i] = a2[0][i >> 1][i & 1]; a[24 + i] = a2[1][i >> 1][i & 1]; }
        float b24[24], b12[12], b6[6], b3[3];
        { const bool hi = (lane & 32) != 0;
#pragma unroll
          for (int i = 0; i < 24; ++i) { const float snd = hi ? a[i] : a[i + 24], kp = hi ? a[i + 24] : a[i]; b24[i] = kp + __shfl_xor(snd, 32); } }
        { const bool hi = (lane & 16) != 0;
#pragma unroll
          for (int i = 0; i < 12; ++i) { const float snd = hi ? b24[i] : b24[i + 12], kp = hi ? b24[i + 12] : b24[i]; b12[i] = kp + __shfl_xor(snd, 16); } }
        { const bool hi = (lane & 8) != 0;
#pragma unroll
          for (int i = 0; i < 6; ++i) { const float snd = hi ? b12[i] : b12[i + 6], kp = hi ? b12[i + 6] : b12[i]; b6[i] = kp + __shfl_xor(snd, 8); } }
        { const bool hi = (lane & 4) != 0;
#pragma unroll
          for (int i = 0; i < 3; ++i) { const float snd = hi ? b6[i] : b6[i + 3], kp = hi ? b6[i + 3] : b6[i]; b3[i] = kp + __shfl_xor(snd, 4); } }
#pragma unroll
        for (int i = 0; i < 3; ++i) { b3[i] += __shfl_xor(b3[i], 2); b3[i] += __shfl_xor(b3[i], 1); }
        if ((lane & 3) == 0) {
            const int base = ((lane >> 5) & 1) * 24 + ((lane >> 4) & 1) * 12 + ((lane >> 3) & 1) * 6 + ((lane >> 2) & 1) * 3;
#pragma unroll
            for (int i = 0; i < 3; ++i) { const int idx = base + i; const int r = idx / 24, gc = idx % 24; G[(size_t)(2 * pr + r) * NGT + gc] = b3[i]; }
        }
    }
}

__device__ __forceinline__ float scan128_sum(float v, LAS float* s_tot) {
    const int lane = threadIdx.x & 63;
#pragma unroll
    for (int o = 1; o < 64; o <<= 1) { const float t = __shfl_up(v, o); if (lane >= o) v += t; }
    if (threadIdx.x == 63) *s_tot = v;
    __syncthreads();
    if (threadIdx.x >= 64 && threadIdx.x < 128) v += *s_tot;
    return v;
}
__device__ __forceinline__ float scan128_max(float v, LAS float* s_tot) {
    const int lane = threadIdx.x & 63;
#pragma unroll
    for (int o = 1; o < 64; o <<= 1) { const float t = __shfl_up(v, o); if (lane >= o) v = fmaxf(v, t); }
    if (threadIdx.x == 63) *s_tot = v;
    __syncthreads();
    if (threadIdx.x >= 64 && threadIdx.x < 128) v = fmaxf(v, *s_tot);
    return v;
}
__device__ __forceinline__ void mlstm_gates(float ipr, float fpr, LAS float* s_li, LAS float* s_lf, LAS float* s_b) {
    const int tid = threadIdx.x;
    float lf = 0.f;
    if (tid < CL) {
        const float fc = softcap(fpr);
        s_li[tid] = softcap(ipr);
        lf = fminf(fc, 0.f) - log1pf(expf(-fabsf(fc)));
    }
    const float b = scan128_sum(lf, s_lf);
    if (tid < CL) s_b[tid] = b;
    __syncthreads();
}
__device__ __forceinline__ void ssd_gates(const Params& p, int t0, int g, LAS float* s_dt, LAS float* s_ac, LAS float* s_tmp) {
    const int tid = threadIdx.x, lane = tid & 63, hh = tid >> 6, head = g * 8 + hh; const float* G = (const float*)(p.ws + WS_G);
    const float g0 = G[(size_t)(t0 + lane) * NGT + 8 + head], g1 = G[(size_t)(t0 + lane + 64) * NGT + 8 + head];
    const float db = p.dt_bias[head], A = -expf(p.a_log[head]);
    float carry = 0.f;
#pragma unroll
    for (int hf = 0; hf < 2; ++hf) { const int s = lane + 64 * hf;
        const float dtv = softplusf((hf ? g1 : g0) + db);
        float v = dtv * A;
#pragma unroll
        for (int o = 1; o < 64; o <<= 1) { const float t = __shfl_up(v, o); if (lane >= o) v += t; }
        v += carry; carry = __shfl(v, 63);
        s_dt[hh * 128 + s] = dtv; s_ac[hh * 128 + s] = v; }
    __syncthreads();
}
struct ConvW { f32x4 w[8]; float b[8]; };
__device__ __forceinline__ void conv_load(const Params& p, int ch, ConvW& cw) {
#pragma unroll
    for (int i = 0; i < 8; ++i) { cw.w[i] = ((const f32x4*)p.conv_w)[ch + i]; cw.b[i] = p.conv_b[ch + i]; }
}
__device__ __forceinline__ void conv8(const u16* P, const ConvW& cw, int t, int tl, int ch, float* out) {
    u32x4 v[4];
#pragma unroll
    for (int w = 0; w < 4; ++w) { const int d = 3 - w, dd = (tl >= d) ? d : 0; v[w] = *(const u32x4*)(P + (size_t)(t - dd) * LDP + PX + ch); }
    float acc[8];
#pragma unroll
    for (int i = 0; i < 8; ++i) acc[i] = cw.b[i];
#pragma unroll
    for (int w = 0; w < 4; ++w) { const float m = (tl >= 3 - w) ? 1.f : 0.f; float f[8]; unpack8(v[w], f);
#pragma unroll
        for (int i = 0; i < 8; ++i) acc[i] += f[i] * (cw.w[i][w] * m); }
#pragma unroll
    for (int i = 0; i < 8; ++i) out[i] = siluf(acc[i]);
}


__device__ __forceinline__ void conv_roll_load(const u16* P, int t0, int tl0, int s0, int ch, u32x4* raw) {
#pragma unroll
    for (int k = 0; k < 11; ++k) { const int tl = tl0 + s0 - 3 + k; const int rr = tl >= 0 ? t0 + s0 - 3 + k : t0; raw[k] = *(const u32x4*)(P + (size_t)rr * LDP + PX + ch); }
}
__device__ __forceinline__ void conv_roll_row(const u32x4* raw, const ConvW& cw, int j, float m0, float* acc) {
#pragma unroll
    for (int e = 0; e < 8; ++e) acc[e] = cw.b[e];
#pragma unroll
    for (int w = 0; w < 4; ++w) { const float mm = (j + w < 3) ? m0 : 1.f; float f[8]; unpack8(raw[j + w], f);
#pragma unroll
        for (int e = 0; e < 8; ++e) acc[e] += f[e] * (cw.w[e][w] * mm); }
#pragma unroll
    for (int e = 0; e < 8; ++e) acc[e] = siluf(acc[e]);
}

constexpr int LP = 136;
struct M2Pre { float ipr, fpr; u32x4 kv[4], vv[8]; };
__device__ __forceinline__ void m2_load(const Params& p, int item, M2Pre& r) {
    const int tid = threadIdx.x, h = item & 3, t0 = (item >> 2) * CL, ss = tid >> 2, part = tid & 3;
    const u16* P = (const u16*)(p.ws + WS_P); const float* G = (const float*)(p.ws + WS_G);
    r.ipr = 0.f; r.fpr = 0.f;
    if (tid < CL) { r.ipr = G[(size_t)(t0 + tid) * NGT + h]; r.fpr = G[(size_t)(t0 + tid) * NGT + 4 + h]; }
    const u16* kr = P + (size_t)(t0 + ss) * LDP + PK + h * 128 + part * 32;
    const u16* vr = P + (size_t)(t0 + ss) * LDP + PV + h * 256 + part * 64;
#pragma unroll
    for (int c = 0; c < 4; ++c) r.kv[c] = *(const u32x4*)(kr + c * 8);
#pragma unroll
    for (int c = 0; c < 8; ++c) r.vv[c] = *(const u32x4*)(vr + c * 8);
}
__device__ __forceinline__ void phase2_mlstm(const Params& p, LAS unsigned char* lds, int item, M2Pre& pre, int next_item) {
    const int tid = threadIdx.x, lane = tid & 63, wave = tid >> 6;
    const int h = item & 3, bc = item >> 2, t0 = bc * CL;
    LAS u16* KT = (LAS u16*)lds;
    LAS u16* VT = (LAS u16*)(lds + 34816);
    LAS float* sm = (LAS float*)(lds + 34816 + 67584);
    LAS float *s_li = sm, *s_lf = sm + 128, *s_b = sm + 256, *s_w = sm + 384;
    const float bi_h = p.b_i[h], bf_h = p.b_f[h];
    const int ss = tid >> 2, part = tid & 3;
    const float ipr = pre.ipr, fpr = pre.fpr;
    float li = 0.f, lf = 0.f;
    if (tid < CL) { const float fc = softcap(fpr + bf_h); li = softcap(ipr + bi_h); lf = fminf(fc, 0.f) - log1pf(expf(-fabsf(fc))); }
    const float bcum = scan128_sum(lf, s_lf);
    float uv = -3.0e38f;
    if (tid < CL) { uv = li - bcum; ((float*)(p.ws + WS_LU))[(size_t)item * 128 + tid] = uv; ((float*)(p.ws + WS_LB))[(size_t)item * 128 + tid] = bcum; }
    float um = uv;
#pragma unroll
    for (int o = 1; o < 64; o <<= 1) um = fmaxf(um, __shfl_xor(um, o));
    if (lane == 0 && wave < 2) s_li[wave] = um;
    if (tid < CL) s_w[tid] = uv;
    __syncthreads();
    const float umax = fmaxf(s_li[0], s_li[1]);
    if (tid == CL - 1) { ((float*)(p.ws + WS_MBL))[item] = bcum; ((float*)(p.ws + WS_MGM))[item] = bcum + umax; }
    (void)s_b;
    {
        const float w = expf(s_w[ss] - umax);
#pragma unroll
        for (int c = 0; c < 4; ++c) { float f[8]; unpack8(pre.kv[c], f);
            u32x4 o; o.x = pk2(f[0] * w, f[1] * w); o.y = pk2(f[2] * w, f[3] * w); o.z = pk2(f[4] * w, f[5] * w); o.w = pk2(f[6] * w, f[7] * w);
            *(LAS u32x4*)(KT + ss * LP + part * 32 + c * 8) = o; }
#pragma unroll
        for (int c = 0; c < 8; ++c) *(LAS u32x4*)(VT + ss * 264 + part * 64 + c * 8) = pre.vv[c];
    }
    m2_load(p, next_item, pre);
    __syncthreads();
    {
        f32x4 nacc = {0.f, 0.f, 0.f, 0.f};
        const bf16x8 ones = {(short)0x3F80, (short)0x3F80, (short)0x3F80, (short)0x3F80, (short)0x3F80, (short)0x3F80, (short)0x3F80, (short)0x3F80};
#pragma unroll
        for (int ks = 0; ks < 4; ++ks) nacc = __builtin_amdgcn_mfma_f32_16x16x32_bf16(ones, frag_tr(KT, LP, ks * 32, wave * 16, lane), nacc, 0, 0, 0);
        if ((lane >> 4) == 0) ((float*)(p.ws + WS_NLOC))[(size_t)item * 128 + wave * 16 + (lane & 15)] = nacc[0];
    }
    f32x4 acc[8][2];
#pragma unroll
    for (int m = 0; m < 8; ++m)
#pragma unroll
        for (int n = 0; n < 2; ++n) acc[m][n] = (f32x4){0.f, 0.f, 0.f, 0.f};
    mma_lds_tt<8, 2, 4>(acc, KT, LP, VT + wave * 32, 264, lane);
    u16* CS = (u16*)p.out + (size_t)item * 32768;
    const int r = lane & 15, q = lane >> 4;
    {
        u16* dst = CS + (wave * 32 + (q & 1) * 16 + r) * 128 + (q >> 1) * 8;
#pragma unroll
        for (int m = 0; m < 8; ++m) {
            unsigned x0 = pk2(acc[m][0][0], acc[m][0][1]), x1 = pk2(acc[m][0][2], acc[m][0][3]);
            unsigned y0 = pk2(acc[m][1][0], acc[m][1][1]), y1 = pk2(acc[m][1][2], acc[m][1][3]);
            auto s0 = __builtin_amdgcn_permlane16_swap(x0, y0, false, false); x0 = s0[0]; y0 = s0[1];
            auto s1 = __builtin_amdgcn_permlane16_swap(x1, y1, false, false); x1 = s1[0]; y1 = s1[1];
            const u32x4 o = {x0, x1, y0, y1};
            *(u32x4*)(dst + m * 16) = o;
        }
    }
    __syncthreads();
}

__device__ __forceinline__ void phase2_ssd(const Params& p, LAS unsigned char* lds, int item) {
    const int tid = threadIdx.x, lane = tid & 63, wave = tid >> 6;
    const int g = item & 1, bc = item >> 1, t0 = bc * CL, tl0 = (bc & (NCH - 1)) * CL;
    const u16* P = (const u16*)(p.ws + WS_P); u16* XC = (u16*)(p.ws + WS_H);
    LAS u16* BN = (LAS u16*)lds;
    LAS u16* XD = (LAS u16*)(lds + 34816);
    LAS float* sm = (LAS float*)(lds + 34816 + 67584);
    LAS float *s_dt = sm, *s_ac = sm + 1024;
    const int cg = tid & 31, s0 = (tid >> 5) * 8;
    u32x4 raw[11];
#define SSD2_LOAD(half) do { _Pragma("unroll") for (int k = 0; k < 11; ++k) { const int tl = tl0 + s0 - 3 + k; const int rr = tl >= 0 ? t0 + s0 - 3 + k : t0; \
        raw[k] = *(const u32x4*)(P + (size_t)rr * LDP + PX + g * 512 + (half) * 256 + cg * 8); } } while (0)
    SSD2_LOAD(0);
    ssd_gates(p, t0, g, s_dt, s_ac, sm + 2048);
    { float* sg = (float*)(p.ws + WS_SG) + (size_t)item * 2048; sg[tid] = s_dt[tid]; sg[tid + 512] = s_dt[tid + 512]; sg[1024 + tid] = s_ac[tid]; sg[1536 + tid] = s_ac[tid + 512]; }
    if (tid < 8) ((float*)(p.ws + WS_SDEC))[item * 8 + tid] = expf(s_ac[tid * 128 + 127]);
    if (tid < 256) {
        const int cgp = tid & 15, sb = (tid >> 4) * 8, chb = 1024 + g * 128 + cgp * 8;
        u32x4 rawb[11]; conv_roll_load(P, t0, tl0, sb, chb, rawb);
        ConvW cw; conv_load(p, chb, cw);
        const float m0 = (tl0 + sb - 3 >= 0) ? 1.f : 0.f;
#pragma unroll
        for (int j = 0; j < 8; ++j) { float f[8]; conv_roll_row(rawb, cw, j, m0, f);
            u32x4 o; o.x = pk2(f[0], f[1]); o.y = pk2(f[2], f[3]); o.z = pk2(f[4], f[5]); o.w = pk2(f[6], f[7]); *(LAS u32x4*)(BN + (sb + j) * LP + cgp * 8) = o; }
    }
    u16* HS = (u16*)p.out + (size_t)1024 * 32768;
    const int r = lane & 15, q = lane >> 4;
#pragma unroll 1
    for (int hb = 0; hb < 2; ++hb) {
        {
            const int ch = g * 512 + hb * 256 + cg * 8, hh = hb * 4 + (cg >> 3);
            ConvW cw; conv_load(p, ch, cw);
            const float alast = s_ac[hh * 128 + 127];
            float m0 = (tl0 + s0 - 3 >= 0) ? 1.f : 0.f;
#pragma unroll
            for (int j = 0; j < 8; ++j) {
                float acc[8];
#pragma unroll
                for (int e = 0; e < 8; ++e) acc[e] = cw.b[e];
#pragma unroll
                for (int w = 0; w < 4; ++w) { const float mm = (j + w < 3) ? m0 : 1.f; float f[8]; unpack8(raw[j + w], f);
#pragma unroll
                    for (int e = 0; e < 8; ++e) acc[e] += f[e] * (cw.w[e][w] * mm); }
#pragma unroll
                for (int e = 0; e < 8; ++e) acc[e] = siluf(acc[e]);
                const int sr = s0 + j; const float sc = s_dt[hh * 128 + sr] * expf(alast - s_ac[hh * 128 + sr]);
                u32x4 o; o.x = pk2(acc[0], acc[1]); o.y = pk2(acc[2], acc[3]); o.z = pk2(acc[4], acc[5]); o.w = pk2(acc[6], acc[7]);
                *(u32x4*)(XC + (size_t)(t0 + sr) * 1024 + ch) = o;
                o.x = pk2(acc[0] * sc, acc[1] * sc); o.y = pk2(acc[2] * sc, acc[3] * sc); o.z = pk2(acc[4] * sc, acc[5] * sc); o.w = pk2(acc[6] * sc, acc[7] * sc);
                *(LAS u32x4*)(XD + sr * 264 + cg * 8) = o;
            }
        }
        if (hb == 0) SSD2_LOAD(1);
        __syncthreads();
        const int h4 = wave >> 1, nh = wave & 1, head = g * 8 + hb * 4 + h4;
        f32x4 acc[4][4];
#pragma unroll
        for (int m = 0; m < 4; ++m)
#pragma unroll
            for (int n = 0; n < 4; ++n) acc[m][n] = (f32x4){0.f, 0.f, 0.f, 0.f};
        mma_lds_tt<4, 4, 4>(acc, BN + nh * 64, LP, XD + h4 * 64, 264, lane);
        u16* dst = HS + ((size_t)bc * 16 + head) * 8192;
#pragma unroll
        for (int m = 0; m < 4; ++m)
#pragma unroll
            for (int n2 = 0; n2 < 4; n2 += 2) {
                unsigned x0 = pk2(acc[m][n2][0], acc[m][n2][1]), x1 = pk2(acc[m][n2][2], acc[m][n2][3]);
                unsigned y0 = pk2(acc[m][n2 + 1][0], acc[m][n2 + 1][1]), y1 = pk2(acc[m][n2 + 1][2], acc[m][n2 + 1][3]);
                auto s0 = __builtin_amdgcn_permlane16_swap(x0, y0, false, false); x0 = s0[0]; y0 = s0[1];
                auto s1 = __builtin_amdgcn_permlane16_swap(x1, y1, false, false); x1 = s1[0]; y1 = s1[1];
                const u32x4 o = {x0, x1, y0, y1};
                *(u32x4*)(dst + ((n2 + (q & 1)) * 16 + r) * 128 + nh * 64 + m * 16 + (q >> 1) * 8) = o; }
        __syncthreads();
    }
#undef SSD2_LOAD
}

__device__ __forceinline__ void phase3(const Params& p) {
    const int gtid = blockIdx.x * NTHR + threadIdx.x, nthr = gridDim.x * NTHR;
    for (int w = gtid; w < 131072; w += nthr) {
        if (w < 65536) {
            const int bh = w >> 12, e8 = w & 4095, b = bh >> 2, h = bh & 3;
            u16* CS = (u16*)p.out; const float* MBL = (const float*)(p.ws + WS_MBL); const float* MGM = (const float*)(p.ws + WS_MGM);
            float* MPREV = (float*)(p.ws + WS_MPREV); float* NL = (float*)(p.ws + WS_NLOC);
            float C[8]; float m = 0.f;
#pragma unroll
            for (int i = 0; i < 8; ++i) C[i] = 0.f;
            u32x4 vn[8]; float an[8], gn[8], nn[8]; float nv = 0.f; const int en = e8 & 127;
#define P3_LOAD(c0_) do { _Pragma("unroll") for (int j = 0; j < 8; ++j) { const int it_ = (b * NCH + (c0_) + j) * 4 + h; vn[j] = *(const u32x4*)(CS + (size_t)it_ * 32768 + e8 * 8); an[j] = MBL[it_]; gn[j] = MGM[it_]; nn[j] = NL[(size_t)it_ * 128 + en]; } } while (0)
            P3_LOAD(0);
#pragma unroll 1
            for (int c0 = 0; c0 < NCH; c0 += 8) {
                u32x4 v[8]; float av[8], gv[8], nl[8];
#pragma unroll
                for (int j = 0; j < 8; ++j) { v[j] = vn[j]; av[j] = an[j]; gv[j] = gn[j]; nl[j] = nn[j]; }
                if (c0 + 8 < NCH) P3_LOAD(c0 + 8);
#pragma unroll
                for (int j = 0; j < 8; ++j) {
                    const int item = (b * NCH + c0 + j) * 4 + h;
                    const float a = av[j], gm = gv[j];
                    const float mn = fmaxf(a + m, gm), so = __expf(a + m - mn), sl = __expf(gm - mn);
                    float f[8]; unpack8(v[j], f);
                    u32x4 o; o.x = pk2(C[0], C[1]); o.y = pk2(C[2], C[3]); o.z = pk2(C[4], C[5]); o.w = pk2(C[6], C[7]);
                    *(u32x4*)(CS + (size_t)item * 32768 + e8 * 8) = o;
#pragma unroll
                    for (int i = 0; i < 8; ++i) C[i] = so * C[i] + sl * f[i];
                    if (e8 < 128) { NL[(size_t)item * 128 + e8] = nv; if (e8 == 0) MPREV[item] = m; }
                    nv = so * nv + sl * nl[j];
                    m = mn;
                }
            }
#undef P3_LOAD
        } else {
            const int idx = w - 65536, bhd = idx >> 10, e8 = idx & 1023, b = bhd >> 4, head = bhd & 15;
            u16* HS = (u16*)p.out + (size_t)1024 * 32768; const float* SD = (const float*)(p.ws + WS_SDEC);
            float hs[8];
#pragma unroll
            for (int i = 0; i < 8; ++i) hs[i] = 0.f;
            u32x4 vn[8]; float dn[8];
#define P3_LOAD(c0_) do { _Pragma("unroll") for (int j = 0; j < 8; ++j) { const int bc_ = b * NCH + (c0_) + j; vn[j] = *(const u32x4*)(HS + ((size_t)bc_ * 16 + head) * 8192 + e8 * 8); dn[j] = SD[(bc_ * 2 + (head >> 3)) * 8 + (head & 7)]; } } while (0)
            P3_LOAD(0);
#pragma unroll 1
            for (int c0 = 0; c0 < NCH; c0 += 8) {
                u32x4 v[8]; float dv[8];
#pragma unroll
                for (int j = 0; j < 8; ++j) { v[j] = vn[j]; dv[j] = dn[j]; }
                if (c0 + 8 < NCH) P3_LOAD(c0 + 8);
#pragma unroll
                for (int j = 0; j < 8; ++j) {
                    const int bc = b * NCH + c0 + j;
                    float f[8]; unpack8(v[j], f);
                    u32x4 o; o.x = pk2(hs[0], hs[1]); o.y = pk2(hs[2], hs[3]); o.z = pk2(hs[4], hs[5]); o.w = pk2(hs[6], hs[7]);
                    *(u32x4*)(HS + ((size_t)bc * 16 + head) * 8192 + e8 * 8) = o;
#pragma unroll
                    for (int i = 0; i < 8; ++i) hs[i] = dv[j] * hs[i] + f[i];
                }
            }
#undef P3_LOAD
        }
    }
}

struct M4Pre { float ipr, fpr, npv, mprev; u32x4 qv[4], kv[4]; };
__device__ __forceinline__ void m4_load(const Params& p, int item, M4Pre& r) {
    const int tid = threadIdx.x, h = item & 3, t0 = (item >> 2) * CL, ss = tid >> 2, part = tid & 3;
    const u16* prow = (const u16*)(p.ws + WS_P) + (size_t)(t0 + ss) * LDP; const float* G = (const float*)(p.ws + WS_G);
    r.ipr = 0.f; r.fpr = 0.f; r.npv = 0.f;
    if (tid < CL) { r.ipr = ((const float*)(p.ws + WS_LU))[(size_t)item * 128 + tid]; r.fpr = ((const float*)(p.ws + WS_LB))[(size_t)item * 128 + tid]; r.npv = ((const float*)(p.ws + WS_NLOC))[(size_t)item * 128 + tid]; }
    (void)G;
    r.mprev = ((const float*)(p.ws + WS_MPREV))[item];
#pragma unroll
    for (int c = 0; c < 4; ++c) { r.qv[c] = *(const u32x4*)(prow + PQ + h * 128 + part * 32 + c * 8); r.kv[c] = *(const u32x4*)(prow + PK + h * 128 + part * 32 + c * 8); }
}
__device__ __forceinline__ void phase4_mlstm(const Params& p, LAS unsigned char* lds, int item, M4Pre& pre, int next_item, bool first) {
    const int tid = threadIdx.x, lane = tid & 63, wave = tid >> 6;
    const int h = item & 3, bc = item >> 2, t0 = bc * CL;
    u16* P = (u16*)(p.ws + WS_P); const float* G = (const float*)(p.ws + WS_G);
    LAS u16* Q = (LAS u16*)lds;
    LAS u16* KS = (LAS u16*)(lds + 34816);
    LAS u16* VT = (LAS u16*)(lds + 69632);
    LAS u16* CP = (LAS u16*)(lds + 104448);
    LAS float* HB = (LAS float*)lds;
    LAS float* sm = (LAS float*)(lds + 139264);
    LAS float *s_li = sm, *s_lf = sm + 128, *s_b = sm + 256, *s_u = sm + 384, *s_M = sm + 512, *s_np = sm + 768;
    const int ss = tid >> 2, part = tid & 3;
    const u16* CS = (const u16*)p.out + (size_t)item * 32768;
    const u16* prow = P + (size_t)(t0 + ss) * LDP;
    const float ipr = pre.ipr, fpr = pre.fpr, npv = pre.npv, mprev = pre.mprev;
    if (first) { if (tid < 256) sm[896 + tid] = p.mnw[h * 256 + tid]; }
    float uv = -3.0e38f;
    if (tid < CL) { uv = ipr; s_u[tid] = uv; s_b[tid] = fpr; s_np[tid] = npv; }
    (void)s_li;
#pragma unroll
    for (int c = 0; c < 4; ++c) { *(LAS u32x4*)(Q + ss * LP + part * 32 + c * 8) = pre.qv[c]; *(LAS u32x4*)(KS + ss * LP + part * 32 + c * 8) = pre.kv[c]; }
    u32x4 vv[4], cv[4];
#pragma unroll
    for (int c = 0; c < 4; ++c) { vv[c] = *(const u32x4*)(prow + PV + h * 256 + part * 32 + c * 8); cv[c] = *(const u32x4*)(CS + (size_t)ss * 128 + part * 32 + c * 8); }
    const float pm = scan128_max(uv, s_lf);
    if (tid < CL) s_M[tid] = fmaxf(mprev, pm);
    const int r = lane & 15, q = lane >> 4;
    f32x4 qnacc = {0.f, 0.f, 0.f, 0.f};
#pragma unroll
    for (int ks = 0; ks < 4; ++ks) {
        const f32x4 n0 = *(const LAS f32x4*)(s_np + ks * 32 + q * 8), n1 = *(const LAS f32x4*)(s_np + ks * 32 + q * 8 + 4);
        const u32x4 nb = {pk2(n0.x, n0.y), pk2(n0.z, n0.w), pk2(n1.x, n1.y), pk2(n1.z, n1.w)};
        qnacc = __builtin_amdgcn_mfma_f32_16x16x32_bf16(*(const LAS bf16x8*)(Q + (wave * 16 + r) * LP + ks * 32 + q * 8), __builtin_bit_cast(bf16x8, nb), qnacc, 0, 0, 0);
    }
    f32x4 sacc[1][8];
#pragma unroll
    for (int n = 0; n < 8; ++n) sacc[0][n] = (f32x4){0.f, 0.f, 0.f, 0.f};
    mma_lds<1, 8, 4>(sacc, Q + wave * 16 * LP, LP, KS, LP, lane);
    __syncthreads();
    float den[4] = {0.f, 0.f, 0.f, 0.f};
    {
        float Mr[4];
#pragma unroll
        for (int i = 0; i < 4; ++i) Mr[i] = s_M[wave * 16 + q * 4 + i];
#pragma unroll
        for (int n = 0; n < 8; ++n) { const int s = n * 16 + r; const float us = s_u[s];
#pragma unroll
            for (int i = 0; i < 4; ++i) { const int j = wave * 16 + q * 4 + i; float wgt = __expf(fminf(us - Mr[i], 0.f)); wgt = (s <= j) ? wgt : 0.f; const float sp = sacc[0][n][i] * wgt; den[i] += sp;
                KS[j * LP + s] = f2bf(sp); } }
    }
#pragma unroll
    for (int i = 0; i < 4; ++i) { den[i] += __shfl_xor(den[i], 1); den[i] += __shfl_xor(den[i], 2); den[i] += __shfl_xor(den[i], 4); den[i] += __shfl_xor(den[i], 8); }
    float isc[4], Mj[4], bj[4], qn[4];
#pragma unroll
    for (int i = 0; i < 4; ++i) { const int j = wave * 16 + q * 4 + i; Mj[i] = s_M[j]; bj[i] = s_b[j]; qn[i] = qnacc[i]; isc[i] = __expf(mprev - Mj[i]); }
#pragma unroll
    for (int c = 0; c < 4; ++c) { *(LAS u32x4*)(VT + ss * LP + part * 32 + c * 8) = vv[c]; *(LAS u32x4*)(CP + ss * LP + part * 32 + c * 8) = cv[c]; }
#pragma unroll
    for (int c = 0; c < 4; ++c) { vv[c] = *(const u32x4*)(prow + PV + h * 256 + 128 + part * 32 + c * 8); cv[c] = *(const u32x4*)(CS + (size_t)(128 + ss) * 128 + part * 32 + c * 8); }
    __syncthreads();
    f32x4 acc[2][1][8];
#pragma unroll
    for (int n = 0; n < 8; ++n) acc[0][0][n] = (f32x4){0.f, 0.f, 0.f, 0.f};
    mma_lds<1, 8, 4>(acc[0], Q + wave * 16 * LP, LP, CP, LP, lane);
#pragma unroll
    for (int n = 0; n < 8; ++n)
#pragma unroll
        for (int i = 0; i < 4; ++i) acc[0][0][n][i] *= isc[i];
    mma_lds_bt<1, 8, 4>(acc[0], KS + wave * 16 * LP, LP, VT, LP, lane);
    __syncthreads();
#pragma unroll
    for (int c = 0; c < 4; ++c) { *(LAS u32x4*)(VT + ss * LP + part * 32 + c * 8) = vv[c]; *(LAS u32x4*)(CP + ss * LP + part * 32 + c * 8) = cv[c]; }
    u16* obase = P + (size_t)(t0 + (tid >> 5)) * LDP + PO + h * 256 + (tid & 31) * 8; const u16* zbase = obase + (PZM - PO);
    u32x4 zvv[8];
#pragma unroll
    for (int it = 0; it < 8; ++it) zvv[it] = *(const u32x4*)(zbase + (size_t)(16 * it) * LDP);
    __syncthreads();
#pragma unroll
    for (int n = 0; n < 8; ++n) acc[1][0][n] = (f32x4){0.f, 0.f, 0.f, 0.f};
    mma_lds<1, 8, 4>(acc[1], Q + wave * 16 * LP, LP, CP, LP, lane);
#pragma unroll
    for (int n = 0; n < 8; ++n)
#pragma unroll
        for (int i = 0; i < 4; ++i) acc[1][0][n][i] *= isc[i];
    mma_lds_bt<1, 8, 4>(acc[1], KS + wave * 16 * LP, LP, VT, LP, lane);
    const float scale = 0.08838834764831845f;
    float fac[4];
#pragma unroll
    for (int i = 0; i < 4; ++i) { const float dt = scale * (den[i] + isc[i] * qn[i]); const float dn = fmaxf(fabsf(dt), __expf(-(bj[i] + Mj[i]))); fac[i] = scale / dn; }
    __syncthreads();
#pragma unroll
    for (int hf = 0; hf < 2; ++hf)
#pragma unroll
        for (int n = 0; n < 8; ++n)
#pragma unroll
            for (int i = 0; i < 4; ++i) HB[(wave * 16 + q * 4 + i) * 260 + hf * 128 + n * 16 + r] = acc[hf][0][n][i] * fac[i];
    __syncthreads();
    m4_load(p, next_item, pre);
    {
        const int j = ss;
        float sq = 0.f;
#pragma unroll
        for (int it = 0; it < 8; ++it) { const int vd = (it * 4 + part) * 8; const f32x4 a = *(const LAS f32x4*)(HB + j * 260 + vd), b = *(const LAS f32x4*)(HB + j * 260 + vd + 4);
            sq += (a.x * a.x + a.y * a.y) + (a.z * a.z + a.w * a.w) + (b.x * b.x + b.y * b.y) + (b.z * b.z + b.w * b.w); }
        sq += __shfl_xor(sq, 1); sq += __shfl_xor(sq, 2);
        if (part == 0) s_u[j] = rsqrtf(sq * (1.f / 256.f) + EPS);
    }
    __syncthreads();
    {
        const int vd = (tid & 31) * 8;
        const f32x4 w0 = *(const LAS f32x4*)(sm + 896 + vd), w1 = *(const LAS f32x4*)(sm + 896 + vd + 4);
        const float wv[8] = {w0.x, w0.y, w0.z, w0.w, w1.x, w1.y, w1.z, w1.w};
#pragma unroll
        for (int it = 0; it < 8; ++it) { const int j = (tid >> 5) + 16 * it; const float rstd = s_u[j];
            const f32x4 a = *(const LAS f32x4*)(HB + j * 260 + vd), b = *(const LAS f32x4*)(HB + j * 260 + vd + 4);
            const float hv[8] = {a.x, a.y, a.z, a.w, b.x, b.y, b.z, b.w};
            float zf[8]; unpack8(zvv[it], zf);
            float y[8];
#pragma unroll
            for (int e = 0; e < 8; ++e) y[e] = hv[e] * rstd * wv[e] * zf[e];
            u32x4 o; o.x = pk2(y[0], y[1]); o.y = pk2(y[2], y[3]); o.z = pk2(y[4], y[5]); o.w = pk2(y[6], y[7]);
            *(u32x4*)(obase + (size_t)(16 * it) * LDP) = o; }
    }
    __syncthreads();
}

__device__ __forceinline__ void phase4_ssd(const Params& p, LAS unsigned char* lds, int item) {
    const int tid = threadIdx.x, lane = tid & 63, wave = tid >> 6;
    const int g = item & 1, bc = item >> 1, t0 = bc * CL, tl0 = (bc & (NCH - 1)) * CL;
    u16* P = (u16*)(p.ws + WS_P); const u16* XC = (const u16*)(p.ws + WS_H);
    LAS u16* CM = (LAS u16*)lds;
    LAS u16* BM = (LAS u16*)(lds + 34816);
#define SSD4_XS(b_) ((LAS u16*)(lds + 34816 + (b_) * 18432))
#define SSD4_ZS(b_) ((LAS u16*)(lds + 71680 + (b_) * 18432))
#define SSD4_HP(b_) ((LAS u16*)(lds + ((b_) ? 132640 : 108544)))
    LAS float* sm = (LAS float*)(lds + 150048);
    LAS float *s_dt = sm, *s_ac = sm + 1024, *s_rs = sm + 2048;
    const u16* HS = (const u16*)p.out + (size_t)1024 * 32768;
    u32x4 zv[2], xv[2], hv[2];
#define SSD4_LOAD(head_) do { _Pragma("unroll") for (int i = 0; i < 2; ++i) { const int ch = tid + NTHR * i, row = ch >> 3, c8 = ch & 7, pp = ch >> 4, c16 = ch & 15; \
        zv[i] = *(const u32x4*)(P + (size_t)(t0 + row) * LDP + PZS + (head_) * 64 + c8 * 8); \
        xv[i] = *(const u32x4*)(XC + (size_t)(t0 + row) * 1024 + (head_) * 64 + c8 * 8); \
        hv[i] = *(const u32x4*)(HS + ((size_t)bc * 16 + (head_)) * 8192 + pp * 128 + c16 * 8); } } while (0)
    if (tid < 8) s_rs[128 + tid] = p.d_skip[g * 8 + tid];
    { const float* sg = (const float*)(p.ws + WS_SG) + (size_t)item * 2048; const float d0 = sg[tid], d1 = sg[tid + 512], a0 = sg[1024 + tid], a1 = sg[1536 + tid];
      s_dt[tid] = d0; s_dt[tid + 512] = d1; s_ac[tid] = a0; s_ac[tid + 512] = a1; }
    __syncthreads();
    {
        const int mat = tid >> 8, t8 = tid & 255, cgp = t8 & 15, sb = (t8 >> 4) * 8, chb = 1024 + mat * 256 + g * 128 + cgp * 8;
        u32x4 rawb[11]; conv_roll_load(P, t0, tl0, sb, chb, rawb);
        ConvW cw; conv_load(p, chb, cw);
        LAS u16* dstt = mat ? CM : BM; const float m0 = (tl0 + sb - 3 >= 0) ? 1.f : 0.f;
#pragma unroll
        for (int j = 0; j < 8; ++j) { float f[8]; conv_roll_row(rawb, cw, j, m0, f);
            u32x4 o; o.x = pk2(f[0], f[1]); o.y = pk2(f[2], f[3]); o.z = pk2(f[4], f[5]); o.w = pk2(f[6], f[7]); *(LAS u32x4*)(dstt + (sb + j) * LP + cgp * 8) = o; }
    }
    SSD4_LOAD(g * 8);
    __syncthreads();
    const int r = lane & 15, q = lane >> 4;
    const int lcol = wave * 16 + r;
    f32x4 cbT[8][1];
#pragma unroll
    for (int m = 0; m < 8; ++m) cbT[m][0] = (f32x4){0.f, 0.f, 0.f, 0.f};
    mma_lds<8, 1, 4>(cbT, BM, LP, CM + wave * 16 * LP, LP, lane);
    float ssq = 0.f;
    __syncthreads();
#define SSD4_STAGE(b_) do { _Pragma("unroll") for (int i = 0; i < 2; ++i) { const int ch = tid + NTHR * i, row = ch >> 3, c8 = ch & 7, pp = ch >> 4, c16 = ch & 15; \
        *(LAS u32x4*)(SSD4_ZS(b_) + row * 72 + c8 * 8) = zv[i]; *(LAS u32x4*)(SSD4_XS(b_) + row * 72 + c8 * 8) = xv[i]; *(LAS u32x4*)(SSD4_HP(b_) + pp * LP + c16 * 8) = hv[i]; } } while (0)
    SSD4_STAGE(0); SSD4_LOAD(g * 8 + 1);
#pragma unroll 1
    for (int hh = 0; hh < 8; ++hh) {
        const int head = g * 8 + hh, cb_ = hh & 1, nb_ = cb_ ^ 1;
        LAS u16* XS = SSD4_XS(cb_); LAS u16* ZS = SSD4_ZS(cb_); LAS u16* HP = SSD4_HP(cb_);
        bf16x8 mfrag[4];
        {
            const float acl = s_ac[hh * 128 + lcol];
#pragma unroll
            for (int ks = 0; ks < 4; ++ks) {
                unsigned pk[4];
#pragma unroll
                for (int hf = 0; hf < 2; ++hf) { const int m = 2 * ks + hf, sb = 16 * m + 4 * q;
                    const f32x4 a4 = *(const LAS f32x4*)(s_ac + hh * 128 + sb), d4 = *(const LAS f32x4*)(s_dt + hh * 128 + sb);
                    float v[4];
#pragma unroll
                    for (int i = 0; i < 4; ++i) { float t = cbT[m][0][i] * __expf(fminf(acl - a4[i], 0.f)) * d4[i]; v[i] = (sb + i <= lcol) ? t : 0.f; }
                    pk[2 * hf] = pk2(v[0], v[1]); pk[2 * hf + 1] = pk2(v[2], v[3]); }
                const u32x4 u = {pk[0], pk[1], pk[2], pk[3]};
                mfrag[ks] = __builtin_bit_cast(bf16x8, u);
            }
        }
        __syncthreads();
        if (hh > 0) {
#pragma unroll
            for (int i = 0; i < 2; ++i) { const int ch = tid + NTHR * i, row = ch >> 3, c8 = ch & 7; const u32x4 yv = *(const LAS u32x4*)(SSD4_ZS(nb_) + row * 72 + c8 * 8);
                *(u32x4*)(P + (size_t)(t0 + row) * LDP + PZS + (head - 1) * 64 + c8 * 8) = yv; }
        }
        if (hh < 7) { if (nb_) SSD4_STAGE(1); else SSD4_STAGE(0); if (hh < 6) SSD4_LOAD(head + 2); }
        f32x4 ya[4][1];
#pragma unroll
        for (int mt = 0; mt < 4; ++mt) ya[mt][0] = (f32x4){0.f, 0.f, 0.f, 0.f};
        mma_lds<4, 1, 4>(ya, HP, LP, CM + wave * 16 * LP, LP, lane);
        { const float ea = __expf(s_ac[hh * 128 + lcol]);
#pragma unroll
          for (int mt = 0; mt < 4; ++mt) ya[mt][0] *= ea; }
#pragma unroll
        for (int ks = 0; ks < 4; ++ks) {
#pragma unroll
            for (int mt = 0; mt < 4; ++mt) {
                const LAS u16* p0 = XS + (32 * ks + 4 * q + (r >> 2)) * 72 + 16 * mt + (r & 3) * 4;
                const v4i16_t lo = __builtin_amdgcn_ds_read_tr16_b64_v4i16((LAS v4i16_t*)p0);
                const v4i16_t hi = __builtin_amdgcn_ds_read_tr16_b64_v4i16((LAS v4i16_t*)(p0 + 16 * 72));
                const bf16x8 af = __builtin_shufflevector(lo, hi, 0, 1, 2, 3, 4, 5, 6, 7);
                ya[mt][0] = __builtin_amdgcn_mfma_f32_16x16x32_bf16(af, mfrag[ks], ya[mt][0], 0, 0, 0);
            }
        }
        const float dsk = s_rs[128 + hh];
        {
            u32x2 xs4[4], zs4[4];
#pragma unroll
            for (int mt = 0; mt < 4; ++mt) { xs4[mt] = *(const LAS u32x2*)(XS + lcol * 72 + 16 * mt + 4 * q); zs4[mt] = *(const LAS u32x2*)(ZS + lcol * 72 + 16 * mt + 4 * q); }
#pragma unroll
            for (int mt = 0; mt < 4; ++mt) {
                const float xf[4] = {bflo(xs4[mt].x), bfhi(xs4[mt].x), bflo(xs4[mt].y), bfhi(xs4[mt].y)};
                const float zf[4] = {bflo(zs4[mt].x), bfhi(zs4[mt].x), bflo(zs4[mt].y), bfhi(zs4[mt].y)};
                float y[4];
#pragma unroll
                for (int i = 0; i < 4; ++i) { y[i] = (ya[mt][0][i] + dsk * xf[i]) * zf[i]; ssq += y[i] * y[i]; }
                u32x2 o; o.x = pk2(y[0], y[1]); o.y = pk2(y[2], y[3]);
                *(LAS u32x2*)(ZS + lcol * 72 + 16 * mt + 4 * q) = o;
            }
        }
    }
#undef SSD4_LOAD
    ssq += __shfl_xor(ssq, 16); ssq += __shfl_xor(ssq, 32);
    if (q == 0) ((float*)(p.ws + WS_RSG))[2 * (size_t)(t0 + lcol) + g] = rsqrtf(ssq * (1.f / 512.f) + EPS);
    __syncthreads();
#pragma unroll
    for (int i = 0; i < 2; ++i) { const int ch = tid + NTHR * i, row = ch >> 3, c8 = ch & 7; const u32x4 yv = *(const LAS u32x4*)(SSD4_ZS(1) + row * 72 + c8 * 8);
        *(u32x4*)(P + (size_t)(t0 + row) * LDP + PZS + (g * 8 + 7) * 64 + c8 * 8) = yv; }
    __syncthreads();
#undef SSD4_STAGE
#undef SSD4_XS
#undef SSD4_ZS
#undef SSD4_HP
}

__device__ __forceinline__ void phase6(const Params& p) {
    const int lane = threadIdx.x & 63, wave = threadIdx.x >> 6;
    const int gw = blockIdx.x * 8 + wave, NGW = gridDim.x * 8;
    const u16* Z = (const u16*)(p.ws + WS_H);
    f32x4 nw[4];
#pragma unroll
    for (int j = 0; j < 4; ++j) nw[j] = ((const f32x4*)p.fnw)[lane + 64 * j];
    for (int r4 = gw; r4 < T / 4; r4 += NGW) {
        u32x2 zv[4][4]; float s[4]; f32x4 f[4][4];
#pragma unroll
        for (int k = 0; k < 4; ++k)
#pragma unroll
            for (int j = 0; j < 4; ++j) { zv[k][j] = ((const u32x2*)(Z + (size_t)(4 * r4 + k) * DM))[lane + 64 * j]; f[k][j] = __builtin_nontemporal_load((const f32x4*)(p.x + (size_t)(4 * r4 + k) * DM) + lane + 64 * j); }
#pragma unroll
        for (int k = 0; k < 4; ++k) { s[k] = 0.f;
#pragma unroll
            for (int j = 0; j < 4; ++j) { f[k][j] += (f32x4){bflo(zv[k][j].x), bfhi(zv[k][j].x), bflo(zv[k][j].y), bfhi(zv[k][j].y)};
                s[k] += (f[k][j].x * f[k][j].x + f[k][j].y * f[k][j].y) + (f[k][j].z * f[k][j].z + f[k][j].w * f[k][j].w); } }
#pragma unroll
        for (int o = 1; o < 64; o <<= 1) {
#pragma unroll
            for (int k = 0; k < 4; ++k) s[k] += __shfl_xor(s[k], o); }
#pragma unroll
        for (int k = 0; k < 4; ++k) { const float rstd = rsqrtf(s[k] * (1.f / DM) + EPS);
#pragma unroll
            for (int j = 0; j < 4; ++j) ((f32x4*)(p.out + (size_t)(4 * r4 + k) * DM))[lane + 64 * j] = f[k][j] * rstd * nw[j]; }
    }
}

__global__ void __launch_bounds__(NTHR) fwd_kernel(Params p) {
    extern __shared__ __attribute__((aligned(16))) unsigned char lds_raw[];
    LAS unsigned char* lds = (LAS unsigned char*)lds_raw;
    cg::grid_group grid = cg::this_grid();
    const int lo = p.ph_lo, hi = p.ph_hi;
    if (lo < 0) grid.sync();
    volatile LAS unsigned* xbst = (volatile LAS unsigned*)(lds + LDS_BYTES - 16);
    if (threadIdx.x < 4) xbst[threadIdx.x] = 0u;
    __syncthreads();
    XcdBarrier bar = xcd_barrier_post((unsigned*)(p.ws + WS_BAR), xbst);
#ifndef PHMASK
#define PHMASK 127
#endif
#define IN(k) (((PHMASK >> (k)) & 1) && lo <= (k) && (k) < hi)
#define SEAM(k) do { if (IN(k) && IN((k) + 1)) xcd_barrier(bar); } while (0)
#ifndef PROBE
#define PROBE 0
#endif
#define GSYNC() do { if (hi - lo > 1) xcd_barrier(bar); } while (0)
#define PH1() do { pg8::Gemm g{(const u16*)(p.ws + WS_H), (const u16*)(p.ws + WS_WTIN), T, LDP, DM, DM}; pg8::StaticOrder S; S.init(T, LDP, gridDim.x, blockIdx.x); \
        pg8::EpiP E{(u16*)(p.ws + WS_P), LDP, nullptr}; pg8::gemm_phase<pg8::EpiP, pg8::StaticOrder>(lds, g, S, E); } while (0)
#define PH2() do { { M2Pre pre_; if ((int)blockIdx.x < 1024) m2_load(p, blockIdx.x, pre_); for (int it = blockIdx.x; it < 1024; it += gridDim.x) { const int nx_ = it + gridDim.x; phase2_mlstm(p, lds, it, pre_, nx_ < 1024 ? nx_ : it); } } \
        for (int it = blockIdx.x; it < 512; it += gridDim.x) phase2_ssd(p, lds, it); } while (0)
#define PH4() do { { M4Pre pre_; if ((int)blockIdx.x < 1024) m4_load(p, blockIdx.x, pre_); for (int it = blockIdx.x; it < 1024; it += gridDim.x) { const int nx_ = it + gridDim.x; phase4_mlstm(p, lds, it, pre_, nx_ < 1024 ? nx_ : it, it == (int)blockIdx.x || (gridDim.x & 3) != 0); } } \
        for (int it = blockIdx.x; it < 512; it += gridDim.x) phase4_ssd(p, lds, it); } while (0)
#define PH5() do { pg8::Gemm g{(const u16*)(p.ws + WS_P) + PO, (const u16*)(p.ws + WS_WTOUT), T, DM, 2048, LDP}; pg8::StaticOrder S; S.init(T, DM, gridDim.x, blockIdx.x); \
        pg8::EpiOut E{(u16*)(p.ws + WS_H), p.x, DM, (const float*)(p.ws + WS_RSG)}; pg8::gemm_phase<pg8::EpiOut, pg8::StaticOrder>(lds, g, S, E); } while (0)
    if (IN(0)) { phase0(p, lds); if (PROBE == 1) { GSYNC(); phase0(p, lds); } }
    SEAM(0);
    if (IN(1)) { PH1(); if (PROBE == 2) { GSYNC(); PH1(); } }
    SEAM(1);
    if (IN(2)) { PH2(); if (PROBE == 3) { GSYNC(); PH2(); } }
    SEAM(2);
    if (IN(3)) { phase3(p); if (PROBE == 4) { GSYNC(); PH2(); GSYNC(); phase3(p); } }
    SEAM(3);
    if (IN(4)) PH4();
    SEAM(4);
    if (IN(5)) { PH5(); if (PROBE == 6) { GSYNC(); PH5(); } }
    SEAM(5);
    if (IN(6)) { phase6(p); if (PROBE == 5) { GSYNC(); PH5(); GSYNC(); phase6(p); } }
#undef IN
#undef SEAM
}

extern "C" void kernel_launch(void* const* d_in, const int* in_sizes, int n_in, void* d_out, int out_size, void* d_ws, size_t ws_size, hipStream_t stream) {
    static int grid = 0;
    if (grid == 0) {
        if (n_in != 14 || out_size != T * DM || ws_size < WS_END) { fprintf(stderr, "kernel_launch: unexpected sizes n_in %d out %d ws %zu (need %zu)\n", n_in, out_size, ws_size, (size_t)WS_END); grid = -1; return; }
        int dev = 0, cus = 0;
        hipGetDevice(&dev); hipDeviceGetAttribute(&cus, hipDeviceAttributeMultiprocessorCount, dev);
        if (hipFuncSetAttribute((const void*)fwd_kernel, hipFuncAttributeMaxDynamicSharedMemorySize, LDS_BYTES) != hipSuccess) { fprintf(stderr, "kernel_launch: hipFuncSetAttribute failed\n"); grid = -1; return; }
        int per_cu = 0;
        if (hipOccupancyMaxActiveBlocksPerMultiprocessor(&per_cu, (const void*)fwd_kernel, NTHR, LDS_BYTES) != hipSuccess || per_cu < 1) { fprintf(stderr, "kernel_launch: occupancy query says %d\n", per_cu); }
        (void)hipGetLastError();
        grid = cus > 0 ? cus : 256;
    }
    if (grid < 0) return;
    Params p{};
    p.x = (const float*)d_in[0]; p.norm_w = (const float*)d_in[1]; p.w_in = (const float*)d_in[2]; p.b_i = (const float*)d_in[3]; p.b_f = (const float*)d_in[4];
    p.conv_w = (const float*)d_in[5]; p.conv_b = (const float*)d_in[6]; p.dt_bias = (const float*)d_in[7]; p.a_log = (const float*)d_in[8]; p.d_skip = (const float*)d_in[9];
    p.mnw = (const float*)d_in[10]; p.snw = (const float*)d_in[11]; p.w_out = (const float*)d_in[12]; p.fnw = (const float*)d_in[13];
    p.out = (float*)d_out; p.ws = (unsigned char*)d_ws;
    (void)hipMemsetAsync((char*)d_ws + WS_BAR, 0, 16384, stream);
#if ONE_LAUNCH
    p.ph_lo = 0; p.ph_hi = 7;
    void* args[] = {&p};
    hipError_t e = hipLaunchCooperativeKernel((const void*)fwd_kernel, dim3(grid), dim3(NTHR), args, LDS_BYTES, stream);
    if (e != hipSuccess) fprintf(stderr, "cooperative launch failed: %s (grid %d)\n", hipGetErrorString(e), grid);
#else
    for (int ph = 0; ph < 7; ++ph) { p.ph_lo = ph; p.ph_hi = ph + 1; hipLaunchKernelGGL(fwd_kernel, dim3(grid), dim3(NTHR), LDS_BYTES, stream, p); }
#endif
}
```

```cpp
#include <hip/hip_runtime.h>
#include <hip/hip_cooperative_groups.h>
#include <cstdio>
namespace cg = cooperative_groups;

#define LAS __attribute__((address_space(3)))
typedef unsigned short u16;
typedef short bf16x8 __attribute__((ext_vector_type(8)));
typedef float f32x4 __attribute__((ext_vector_type(4)));
typedef float f32x2 __attribute__((ext_vector_type(2)));
typedef unsigned u32x4 __attribute__((ext_vector_type(4)));
typedef unsigned u32x2 __attribute__((ext_vector_type(2)));
typedef __bf16 bf16x2_t __attribute__((ext_vector_type(2)));

#ifndef ONE_LAUNCH
#define ONE_LAUNCH 1
#endif

constexpr int T = 32768, DM = 1024, SEQ = 8192, NCH = 64, CL = 128;
constexpr int DIN = 6680;
constexpr int LDP = 6656;
constexpr int PQ = 0, PK = 512, PV = 1024, PZM = 2048, PO = 3072, PZS = 4096, PX = 5120, PBM = 6144, PCM = 6400;
constexpr int NGT = 32;
constexpr float EPS = 1e-6f, CAP = 15.0f;
constexpr int NTHR = 512;
constexpr int LDS_BYTES = 163840;

constexpr size_t WS_WTIN = 0;
constexpr size_t WS_WTOUT = WS_WTIN + (size_t)LDP * DM * 2;
constexpr size_t WS_G = WS_WTOUT + (size_t)1024 * 2048 * 2;
constexpr size_t WS_NLOC = WS_G + (size_t)T * NGT * 4;
constexpr size_t WS_MBL = WS_NLOC + (size_t)1024 * 128 * 4;
constexpr size_t WS_MGM = WS_MBL + 4096;
constexpr size_t WS_MPREV = WS_MGM + 4096;
constexpr size_t WS_SDEC = WS_MPREV + 4096;
constexpr size_t WS_BAR = WS_SDEC + 16384;
constexpr size_t WS_RSG = WS_BAR + 16384;
constexpr size_t WS_LU = WS_RSG + (size_t)T * 2 * 4;
constexpr size_t WS_LB = WS_LU + (size_t)1024 * 128 * 4;
constexpr size_t WS_SG = WS_LB + (size_t)1024 * 128 * 4;
constexpr size_t WS_H = WS_SG + (size_t)512 * 2048 * 4;
constexpr size_t WS_P = WS_H + (size_t)T * DM * 2;
constexpr size_t WS_END = WS_P + (size_t)T * LDP * 2;

struct Params {
    const float *x, *norm_w, *w_in, *b_i, *b_f, *conv_w, *conv_b, *dt_bias, *a_log, *d_skip, *mnw, *snw, *w_out, *fnw;
    float* out; unsigned char* ws; int ph_lo, ph_hi;
};

__device__ __forceinline__ unsigned pk2(float lo, float hi) { f32x2 v = {lo, hi}; bf16x2_t b = __builtin_convertvector(v, bf16x2_t); return __builtin_bit_cast(unsigned, b); }
__device__ __forceinline__ u16 f2bf(float f) { return (u16)(pk2(f, 0.f) & 0xffffu); }
__device__ __forceinline__ float bf2f(u16 b) { return __uint_as_float((unsigned)b << 16); }
__device__ __forceinline__ float bflo(unsigned u) { return __uint_as_float(u << 16); }
__device__ __forceinline__ float bfhi(unsigned u) { return __uint_as_float(u & 0xffff0000u); }
__device__ __forceinline__ void unpack8(const u32x4 v, float* f) {
    f[0] = bflo(v.x); f[1] = bfhi(v.x); f[2] = bflo(v.y); f[3] = bfhi(v.y); f[4] = bflo(v.z); f[5] = bfhi(v.z); f[6] = bflo(v.w); f[7] = bfhi(v.w);
}
__device__ __forceinline__ float wave_sum(float v) {
#pragma unroll
    for (int o = 1; o < 64; o <<= 1) v += __shfl_xor(v, o);
    return v;
}
__device__ __forceinline__ float siluf(float v) { return v * __builtin_amdgcn_rcpf(1.f + __expf(-v)); }
__device__ __forceinline__ float sigmf(float v) { return __builtin_amdgcn_rcpf(1.f + __expf(-v)); }
__device__ __forceinline__ float softplusf(float v) { return fmaxf(v, 0.f) + log1pf(expf(-fabsf(v))); }
__device__ __forceinline__ float softcap(float v) { return CAP * tanhf(v * (1.0f / CAP)); }
#define LDS_WAIT() asm volatile("s_waitcnt lgkmcnt(0)" ::: "memory")

template <int MT, int NT, int KS>
__device__ __forceinline__ void mma_lds(f32x4 (&acc)[MT][NT], const LAS u16* A, int lda, const LAS u16* B, int ldb, int lane) {
    const int r = lane & 15, q = lane >> 4;
#pragma unroll
    for (int ks = 0; ks < KS; ++ks) {
        asm volatile("" ::: "memory");
        bf16x8 a[MT], b[NT];
#pragma unroll
        for (int m = 0; m < MT; ++m) a[m] = *(const LAS bf16x8*)(A + (m * 16 + r) * lda + ks * 32 + q * 8);
#pragma unroll
        for (int n = 0; n < NT; ++n) b[n] = *(const LAS bf16x8*)(B + (n * 16 + r) * ldb + ks * 32 + q * 8);
#pragma unroll
        for (int m = 0; m < MT; ++m)
#pragma unroll
            for (int n = 0; n < NT; ++n) acc[m][n] = __builtin_amdgcn_mfma_f32_16x16x32_bf16(a[m], b[n], acc[m][n], 0, 0, 0);
    }
}


typedef short v4i16_t __attribute__((ext_vector_type(4)));
__device__ __forceinline__ bf16x8 frag_tr(const LAS u16* X, int ld, int k0, int n0, int lane) {
    const int g = lane >> 4, a = lane & 15;
    const LAS u16* p0 = X + (k0 + 8 * g + (a >> 2)) * ld + n0 + (a & 3) * 4;
    const v4i16_t lo = __builtin_amdgcn_ds_read_tr16_b64_v4i16((LAS v4i16_t*)p0);
    const v4i16_t hi = __builtin_amdgcn_ds_read_tr16_b64_v4i16((LAS v4i16_t*)(p0 + 4 * ld));
    return __builtin_shufflevector(lo, hi, 0, 1, 2, 3, 4, 5, 6, 7);
}
template <int MT, int NT, int KS>
__device__ __forceinline__ void mma_lds_bt(f32x4 (&acc)[MT][NT], const LAS u16* A, int lda, const LAS u16* B, int ldb, int lane) {
    const int r = lane & 15, q = lane >> 4;
#pragma unroll
    for (int ks = 0; ks < KS; ++ks) {
        asm volatile("" ::: "memory");
        bf16x8 a[MT], b[NT];
#pragma unroll
        for (int m = 0; m < MT; ++m) a[m] = *(const LAS bf16x8*)(A + (m * 16 + r) * lda + ks * 32 + q * 8);
#pragma unroll
        for (int n = 0; n < NT; ++n) b[n] = frag_tr(B, ldb, ks * 32, n * 16, lane);
#pragma unroll
        for (int m = 0; m < MT; ++m)
#pragma unroll
            for (int n = 0; n < NT; ++n) acc[m][n] = __builtin_amdgcn_mfma_f32_16x16x32_bf16(a[m], b[n], acc[m][n], 0, 0, 0);
    }
}
template <int MT, int NT, int KS>
__device__ __forceinline__ void mma_lds_tt(f32x4 (&acc)[MT][NT], const LAS u16* A, int lda, const LAS u16* B, int ldb, int lane) {
#pragma unroll
    for (int ks = 0; ks < KS; ++ks) {
        asm volatile("" ::: "memory");
        bf16x8 a[MT], b[NT];
#pragma unroll
        for (int m = 0; m < MT; ++m) a[m] = frag_tr(A, lda, ks * 32, m * 16, lane);
#pragma unroll
        for (int n = 0; n < NT; ++n) b[n] = frag_tr(B, ldb, ks * 32, n * 16, lane);
#pragma unroll
        for (int m = 0; m < MT; ++m)
#pragma unroll
            for (int n = 0; n < NT; ++n) acc[m][n] = __builtin_amdgcn_mfma_f32_16x16x32_bf16(a[m], b[n], acc[m][n], 0, 0, 0);
    }
}

namespace pg8 {
constexpr int BM = 256, BK = 64, HALF = 128, HTB = HALF * BK * 2, STAGE_BYTES = 8 * HTB, NXCD = 8, WGM = 8;
__device__ __forceinline__ int lds_byte(int r, int c) { const int st = (r >> 4) * 2 + (c >> 5), rr = r & 15, cc = c & 31, ob = rr * 64 + cc * 2; return st * 1024 + (ob ^ (((ob >> 9) & 1) << 5)); }
__device__ __forceinline__ void stage_rc(int b, int& R, int& C) { const int st = b / 1024, sb = b % 1024, swz = sb ^ (((sb >> 9) & 1) << 5); R = (st >> 1) * 16 + swz / 64; C = (st & 1) * 32 + (swz % 64) / 2; }
__device__ __forceinline__ int perm32(int rho) { const int n = rho >> 4, i = rho & 15; return 8 * (i >> 2) + 4 * n + (i & 3); }
struct Unit { int pm, pn; };
struct Gemm { const u16* A; const u16* Bt; int M, N, K, lda; };
struct StaticOrder {
    int nM, nN, nwg, G, c;
    __device__ void init(int M, int N, int G_, int c_) { nM = M / BM; nN = N / BM; nwg = nM * nN; G = G_; c = c_; }
    __device__ bool next(int i, Unit& u) const {
        const long Lx = (long)i * G + c; if (Lx >= nwg) return false;
        int wgid = (int)Lx; { const int q = nwg / NXCD, r = nwg % NXCD, xcd = wgid % NXCD, off = wgid / NXCD; wgid = (xcd < r ? xcd * (q + 1) : r * (q + 1) + (xcd - r) * q) + off; }
        const int nig = WGM * nN, gid = wgid / nig, fm = gid * WGM, gsz = (nM - fm) < WGM ? (nM - fm) : WGM;
        u.pm = fm + ((wgid % nig) % gsz); u.pn = (wgid % nig) / gsz; return true;
    }
};
struct EpiP {
    static constexpr bool PERM = true, HORNER = false;
    u16* O; int ldc; const float* rsg;
    __device__ __forceinline__ void operator()(const f32x4 (&acc)[2][2][4][2], const Unit& u, int wr, int wc, int fr, int fq) const {
        const int row0 = u.pm * BM + wr * 64 + fr; const int col0 = u.pn * BM + wc * 32 + 8 * fq;
        if (u.pn >= 8 && u.pn < 16) {
            const int gcol = 2048 + 128 * (u.pn - 8) + wc * 32 + 8 * fq;
#pragma unroll
            for (int ai = 0; ai < 2; ++ai)
#pragma unroll
                for (int m = 0; m < 4; ++m) { u16* rowp = O + (size_t)(row0 + ai * HALF + m * 16) * ldc + gcol;
                    float gt[8];
#pragma unroll
                    for (int n = 0; n < 2; ++n)
#pragma unroll
                        for (int i = 0; i < 4; ++i) { const float zo = acc[ai][1][m][n][i]; gt[n * 4 + i] = zo * __builtin_amdgcn_rcpf((1.f + __expf(-acc[ai][0][m][n][i])) * (1.f + __expf(-zo))); }
                    u32x4 w; w.x = pk2(gt[0], gt[1]); w.y = pk2(gt[2], gt[3]); w.z = pk2(gt[4], gt[5]); w.w = pk2(gt[6], gt[7]);
                    __builtin_nontemporal_store(w, (u32x4*)rowp); }
            return;
        }
        const bool zs_tile = u.pn >= 16 && u.pn < 20;
        const bool lo = fr < 8; const int colb = u.pn * BM + wc * 64 + 8 * fq + (lo ? 0 : 32), rowb = u.pm * BM + wr * 64 + (fr & 7);
#pragma unroll
        for (int ai = 0; ai < 2; ++ai)
#pragma unroll
            for (int m = 0; m < 4; ++m) {
                u32x4 xy[2];
#pragma unroll
                for (int bj = 0; bj < 2; ++bj) { f32x4 v0 = acc[ai][bj][m][0], v1 = acc[ai][bj][m][1];
                    if (zs_tile) {
#pragma unroll
                        for (int i = 0; i < 4; ++i) { v0[i] = siluf(v0[i]); v1[i] = siluf(v1[i]); } }
                    xy[bj].x = pk2(v0[0], v0[1]); xy[bj].y = pk2(v0[2], v0[3]); xy[bj].z = pk2(v1[0], v1[1]); xy[bj].w = pk2(v1[2], v1[3]); }
                const u32x4 snd = lo ? xy[1] : xy[0]; u32x4 rcv;
                rcv.x = (unsigned)__shfl_xor((int)snd.x, 8); rcv.y = (unsigned)__shfl_xor((int)snd.y, 8); rcv.z = (unsigned)__shfl_xor((int)snd.z, 8); rcv.w = (unsigned)__shfl_xor((int)snd.w, 8);
                const u32x4 dA = lo ? xy[0] : rcv, dB = lo ? rcv : xy[1];
                u16* rp = O + (size_t)(rowb + ai * HALF + m * 16) * ldc + colb;
                __builtin_nontemporal_store(dA, (u32x4*)rp);
                __builtin_nontemporal_store(dB, (u32x4*)(rp + (size_t)8 * ldc)); }
    }
};
struct EpiOut {
    static constexpr bool PERM = true, HORNER = true;
    u16* Z; const float* res; int ldc; const float* rsg;
    __device__ __forceinline__ void operator()(const f32x4 (&acc)[2][2][4][2], const Unit& u, int wr, int wc, int fr, int fq, const LAS unsigned char* fac) const {
        const int row0 = u.pm * BM + wr * 64 + fr, col0 = u.pn * BM + wc * 64 + 8 * fq;
#pragma unroll
        for (int ai = 0; ai < 2; ++ai)
#pragma unroll
            for (int m = 0; m < 4; ++m) { u16* rowp = Z + (size_t)(row0 + ai * HALF + m * 16) * ldc + col0;
                const float r1 = ((const LAS float*)fac)[2 * (ai * HALF + wr * 64 + m * 16 + fr) + 1];
#pragma unroll
                for (int bj = 0; bj < 2; ++bj) { const f32x4 v0 = acc[ai][bj][m][0] * r1, v1 = acc[ai][bj][m][1] * r1;
                    u32x4 w; w.x = pk2(v0[0], v0[1]); w.y = pk2(v0[2], v0[3]); w.z = pk2(v1[0], v1[1]); w.w = pk2(v1[2], v1[3]);
                    *(u32x4*)(rowp + bj * 32) = w; } }
    }
};

template <class Epi, class Sched>
__device__ __forceinline__ void gemm_phase(LAS unsigned char* lds, const Gemm g, const Sched& S, const Epi& E) {
    const int tid = threadIdx.x, wid = __builtin_amdgcn_readfirstlane(tid >> 6), lane = tid & 63, wr = wid >> 2, wc = wid & 3, fr = lane & 15, fq = lane >> 4;
    const int K = g.K, nt = K / BK, lda = g.lda;
    unsigned voffA[2], voffB[2];
#pragma unroll
    for (int i = 0; i < 2; ++i) { int R, C; stage_rc(tid * 16 + i * 8192, R, C); const int Rb = Epi::PERM ? ((R >> 5) * 64 + perm32(R & 31)) : R;
        voffA[i] = (unsigned)(R * lda + C) * 2u; voffB[i] = (unsigned)(Rb * K + C) * 2u; }
    const size_t kstep = (size_t)(BK * 2);
    const size_t hstepA = (size_t)HALF * lda * 2, hstepB = (size_t)(Epi::PERM ? 32 : HALF) * K * 2;
    const size_t tstepA = 2 * hstepA, tstepB = (size_t)BM * K * 2;
    const unsigned ldsw = (unsigned)wid * 1024u;
    const int aoff = lds_byte(wr * 64 + fr, fq * 8), boff = lds_byte(wc * 32 + fr, fq * 8);
#define PG8_SA(b, h) (((b) * 2 + (h)) * HTB)
#define PG8_SB(b, h) ((4 + (b) * 2 + (h)) * HTB)
#define PG8_STAGE(bufoff, gbase, voff) do { _Pragma("unroll") for (int _i = 0; _i < 2; ++_i) \
        __builtin_amdgcn_global_load_lds((const unsigned*)((const char*)(gbase) + (voff)[_i]), (LAS unsigned*)(lds + (bufoff) + ldsw + _i * 8192), 16, 0, 0); } while (0)
#define PG8_LDA(dst, b, h) do { _Pragma("unroll") for (int m = 0; m < 4; ++m) _Pragma("unroll") for (int k = 0; k < 2; ++k) dst[m][k] = *(const LAS bf16x8*)(lds + PG8_SA(b, h) + aoff + m * 2048 + k * 1024); } while (0)
#define PG8_LDB(dst, b, h) do { _Pragma("unroll") for (int n = 0; n < 2; ++n) _Pragma("unroll") for (int k = 0; k < 2; ++k) dst[n][k] = *(const LAS bf16x8*)(lds + PG8_SB(b, h) + boff + n * 2048 + k * 1024); } while (0)
#define PG8_MMA(ai, bj, At, Bt) do { __builtin_amdgcn_s_setprio(1); _Pragma("unroll") for (int m = 0; m < 4; ++m) _Pragma("unroll") for (int n = 0; n < 2; ++n) _Pragma("unroll") for (int k = 0; k < 2; ++k) \
        acc[ai][bj][m][n] = __builtin_amdgcn_mfma_f32_16x16x32_bf16(Bt[n][k], At[m][k], acc[ai][bj][m][n], 0, 0, 0); __builtin_amdgcn_s_setprio(0); } while (0)
#define PG8_WAIT_V(n) asm volatile("s_waitcnt vmcnt(" #n ")" ::: "memory")
#define PG8_WAIT_L(n) asm volatile("s_waitcnt lgkmcnt(" #n ")" ::: "memory")
#define PG8_BAR __builtin_amdgcn_s_barrier()
#define PG8_SCHED __builtin_amdgcn_sched_barrier(0)
    Unit cur, nxt; int ui = 0;
    if (!S.next(0, cur)) return;
    f32x4 acc[2][2][4][2];
#pragma unroll
    for (int a = 0; a < 2; ++a)
#pragma unroll
        for (int b = 0; b < 2; ++b)
#pragma unroll
            for (int m = 0; m < 4; ++m)
#pragma unroll
                for (int n = 0; n < 2; ++n) acc[a][b][m][n] = (f32x4){0.f, 0.f, 0.f, 0.f};
    bf16x8 At[4][2], B0[2][2], B1[2][2];
    const char* cA = (const char*)g.A + (size_t)cur.pm * tstepA; const char* cB = (const char*)g.Bt + (size_t)cur.pn * tstepB;
#define PG8_AK(t_) ((size_t)(t_) * kstep)
#define PG8_HLOAD(u_) do { if constexpr (Epi::HORNER) { __builtin_amdgcn_global_load_lds((const unsigned*)(E.rsg + 2 * (size_t)(u_).pm * BM + tid), (LAS unsigned*)(lds + STAGE_BYTES + (ui & 1) * 2048 + wid * 256), 4, 0, 0); } } while (0)
#define PG8_HSCALE(second_) do { _Pragma("unroll") for (int ai = 0; ai < 2; ++ai) _Pragma("unroll") for (int m = 0; m < 4; ++m) { asm volatile("" ::: "memory"); \
        const f32x2 rr_ = *(const LAS f32x2*)(lds + STAGE_BYTES + (ui & 1) * 2048 + 8 * (ai * HALF + wr * 64 + m * 16 + fr)); const float hf_ = (second_) ? rr_.x * __builtin_amdgcn_rcpf(rr_.y) : __builtin_amdgcn_rcpf(rr_.x); \
        _Pragma("unroll") for (int bj = 0; bj < 2; ++bj) _Pragma("unroll") for (int n = 0; n < 2; ++n) acc[ai][bj][m][n] *= hf_; } } while (0)
    PG8_HLOAD(cur);
    PG8_STAGE(PG8_SB(0, 0), cB, voffB); PG8_STAGE(PG8_SA(0, 0), cA + PG8_AK(0), voffA); PG8_STAGE(PG8_SB(0, 1), cB + hstepB, voffB); PG8_STAGE(PG8_SA(0, 1), cA + PG8_AK(0) + hstepA, voffA);
    if (wr == 1) PG8_BAR;
    PG8_WAIT_V(4); PG8_BAR;
    PG8_STAGE(PG8_SB(1, 0), cB + kstep, voffB); PG8_STAGE(PG8_SA(1, 0), cA + PG8_AK(1), voffA); PG8_STAGE(PG8_SB(1, 1), cB + hstepB + kstep, voffB);
    PG8_WAIT_V(6); PG8_BAR;
    for (;;) {
        const bool has_next = S.next(ui + 1, nxt);
        const char* nA = has_next ? (const char*)g.A + (size_t)nxt.pm * tstepA : cA; const char* nB = has_next ? (const char*)g.Bt + (size_t)nxt.pn * tstepB : cB;
#pragma unroll 1
        for (int seg = 0; seg < (Epi::HORNER ? 3 : 1); ++seg) {
        const int tb = Epi::HORNER ? (seg == 0 ? 0 : (seg == 1 ? 16 : 24)) : 0, te = Epi::HORNER ? (seg == 0 ? 16 : (seg == 1 ? 24 : nt)) : nt;
        if constexpr (Epi::HORNER) { if (seg > 0) PG8_HSCALE(seg == 2); }
#pragma unroll 1
        for (int t = tb; t < te; t += 2) {
            const bool last = (t == nt - 2);
            const char* a1 = cA + PG8_AK(t + 1);
            const char* a2 = last ? nA + PG8_AK(0) : cA + PG8_AK(t + 2); const char* b2 = last ? nB : cB + (size_t)(t + 2) * kstep;
            const char* a3 = last ? nA + PG8_AK(1) : cA + PG8_AK(t + 3); const char* b3 = b2 + kstep;
            PG8_LDB(B0, 0, 0); PG8_SCHED; PG8_LDA(At, 0, 0); PG8_STAGE(PG8_SA(1, 1), a1 + hstepA, voffA);
            PG8_WAIT_L(8); PG8_BAR; PG8_WAIT_L(0); PG8_MMA(0, 0, At, B0); PG8_BAR; PG8_SCHED;
            PG8_LDB(B1, 0, 1); PG8_STAGE(PG8_SB(0, 0), b2, voffB);
            PG8_BAR; PG8_WAIT_L(0); PG8_MMA(0, 1, At, B1); PG8_BAR;
            PG8_LDA(At, 0, 1); PG8_STAGE(PG8_SA(0, 0), a2, voffA);
            PG8_BAR; PG8_WAIT_L(0); PG8_MMA(1, 0, At, B0); PG8_BAR; PG8_SCHED;
            PG8_STAGE(PG8_SB(0, 1), b2 + hstepB, voffB);
            PG8_WAIT_V(6); PG8_BAR; PG8_MMA(1, 1, At, B1); PG8_BAR;
            PG8_LDB(B0, 1, 0); PG8_SCHED; PG8_LDA(At, 1, 0); PG8_STAGE(PG8_SA(0, 1), a2 + hstepA, voffA);
            PG8_WAIT_L(8); PG8_BAR; PG8_WAIT_L(0); PG8_MMA(0, 0, At, B0); PG8_BAR; PG8_SCHED;
            PG8_LDB(B1, 1, 1); PG8_STAGE(PG8_SB(1, 0), b3, voffB);
            PG8_BAR; PG8_WAIT_L(0); PG8_MMA(0, 1, At, B1); PG8_BAR;
            PG8_LDA(At, 1, 1); PG8_STAGE(PG8_SA(1, 0), a3, voffA);
            PG8_BAR; PG8_WAIT_L(0); PG8_MMA(1, 0, At, B0); PG8_BAR; PG8_SCHED;
            PG8_STAGE(PG8_SB(1, 1), b3 + hstepB, voffB);
            PG8_WAIT_V(6); PG8_BAR; PG8_MMA(1, 1, At, B1); PG8_BAR;
        }
        }
        if constexpr (Epi::HORNER) E(acc, cur, wr, wc, fr, fq, lds + STAGE_BYTES + (ui & 1) * 2048); else E(acc, cur, wr, wc, fr, fq);
        if (!has_next) break;
#pragma unroll
        for (int a = 0; a < 2; ++a)
#pragma unroll
            for (int b = 0; b < 2; ++b)
#pragma unroll
                for (int m = 0; m < 4; ++m)
#pragma unroll
                    for (int n = 0; n < 2; ++n) acc[a][b][m][n] = (f32x4){0.f, 0.f, 0.f, 0.f};
        cur = nxt; cA = nA; cB = nB; ++ui;
        PG8_HLOAD(cur);
    }
    PG8_WAIT_V(0);
    if (wr == 0) PG8_BAR;
    PG8_BAR;
#undef PG8_AK
#undef PG8_HLOAD
#undef PG8_HSCALE
#undef PG8_SA
#undef PG8_SB
#undef PG8_STAGE
#undef PG8_LDA
#undef PG8_LDB
#undef PG8_MMA
#undef PG8_WAIT_V
#undef PG8_WAIT_L
#undef PG8_BAR
#undef PG8_SCHED
}
}

#include <hip/hip_runtime.h>
#include <cstdio>

#define XB_TMO      128
#define XB_XCNT(j)  (256  + 64 * (j))
#define XB_XSUB(j)  (1280 + 64 * (j))
#define XB_XGEN(j)  (2304 + 64 * (j))
#define XB_TOP      3328
#define XB_TOPGEN   3392
#define XCD_BAR_WORDS 3456
#define XB_SPIN_CAP (1u << 18)

__device__ __forceinline__ unsigned xb_ld(unsigned* p)              { return __hip_atomic_load(p, __ATOMIC_RELAXED, __HIP_MEMORY_SCOPE_AGENT); }
__device__ __forceinline__ unsigned xb_add(unsigned* p, unsigned v) { return __hip_atomic_fetch_add(p, v, __ATOMIC_RELAXED, __HIP_MEMORY_SCOPE_AGENT); }
__device__ __forceinline__ unsigned xb_xcc_id() { return (unsigned)__builtin_amdgcn_s_getreg((3 << 11) | 20) & 0xFu; }
#define XB_SPIN(cond, bar) do { unsigned _sp = 0; while (cond) { __builtin_amdgcn_s_sleep(1); \
    if ((++_sp & 255u) == 0u) { if (xb_ld(&(bar)[XB_TMO])) break; if (_sp > XB_SPIN_CAP) { atomicAdd(&(bar)[XB_TMO], 1u); break; } } } } while (0)

struct XcdBarrier {
    unsigned* bar; unsigned x;
    volatile LAS unsigned* st;
};

__device__ __forceinline__ XcdBarrier xcd_barrier_post(unsigned* bar, volatile LAS unsigned* st) {
    XcdBarrier b; b.bar = bar; b.x = xb_xcc_id(); b.st = st;
    if (threadIdx.x == 0) (void)xb_add(&bar[XB_XCNT(b.x)], 1u);
    return b;
}
__device__ __forceinline__ void xcd_barrier_complete(unsigned* bar, unsigned x, unsigned& nloc, unsigned& nx) {
    const unsigned G = gridDim.x * gridDim.y * gridDim.z;
    unsigned sum, cnt, mine, sp = 0u;
    for (;;) {
        sum = 0u; cnt = 0u; mine = 0u;
#pragma unroll
        for (unsigned j = 0; j < 16; ++j) { const unsigned c = xb_ld(&bar[XB_XCNT(j)]); sum += c; cnt += (c > 0u) ? 1u : 0u; mine = (j == x) ? c : mine; }
        if (sum == G) break;
        __builtin_amdgcn_s_sleep(1);
        if ((++sp & 255u) == 0u) { if (xb_ld(&bar[XB_TMO])) break; if (sp > XB_SPIN_CAP) { atomicAdd(&bar[XB_TMO], 1u); break; } }
    }
    nloc = mine > 0u ? mine : 1u; nx = cnt > 0u ? cnt : 1u;
}

__device__ __forceinline__ void xcd_barrier(const XcdBarrier& b) {
    asm volatile("s_waitcnt vmcnt(0)" ::: "memory");
    __syncthreads();
    if (threadIdx.x == 0) {
        unsigned* bar = b.bar;
        __builtin_amdgcn_s_waitcnt(0);
        unsigned nloc = b.st[0], nx = b.st[1];
        if (nloc == 0u) { xcd_barrier_complete(bar, b.x, nloc, nx); b.st[0] = nloc; b.st[1] = nx; }
        const unsigned old = xb_add(&bar[XB_XSUB(b.x)], 1u);
        const unsigned gen = old / nloc;
        if (old + 1u == (gen + 1u) * nloc) {
            __builtin_amdgcn_fence(__ATOMIC_RELEASE, "agent");
            asm volatile("s_waitcnt vmcnt(0)" ::: "memory");
            const unsigned og = xb_add(&bar[XB_TOP], 1u);
            const unsigned tg = og / nx;
            if (og + 1u == (tg + 1u) * nx) xb_add(&bar[XB_TOPGEN], 1u);
            else XB_SPIN(xb_ld(&bar[XB_TOPGEN]) == tg, bar);
            __builtin_amdgcn_fence(__ATOMIC_ACQUIRE, "agent");
            xb_add(&bar[XB_XGEN(b.x)], 1u);
            asm volatile("s_waitcnt vmcnt(0)" ::: "memory");
        } else {
            XB_SPIN(xb_ld(&bar[XB_XGEN(b.x)]) == gen, bar);
            __builtin_amdgcn_fence(__ATOMIC_ACQUIRE, "agent");
            asm volatile("s_waitcnt vmcnt(0)" ::: "memory");
        }
    }
    __syncthreads();
}

__device__ __forceinline__ int src_col(int n) {
    if (n < 2048) return n;
    if (n < 4096) { const int cb = (n - 2048) >> 8, off = (n - 2048) & 255;
        const int w = off >> 6, hsel = (off >> 5) & 1; return (hsel ? 3080 : 2056) + 128 * cb + 32 * w; }
    if (n < 5120) return 4104 + (n - 4096);
    return 5128 + (n - 5120);
}
__device__ __forceinline__ void transpose_item(const float* W, int ldw, int K, int srccol, u16* WT, int dstrow, LAS float* scr, int k0, int lane, int k0src, const float* rs) {
#pragma unroll 8
    for (int i = 0; i < 32; ++i) { const int kk = 2 * i + (lane >> 5); float v = W[(size_t)(k0src + kk) * ldw + srccol + (lane & 31)]; if (rs) v *= rs[k0 + kk]; scr[kk * 33 + (lane & 31)] = v; }
    LDS_WAIT();
    const int c = lane & 7;
#pragma unroll
    for (int j = 0; j < 4; ++j) { const int n = (lane >> 3) + 8 * j; const LAS float* s = scr + (8 * c) * 33 + n;
        u32x4 o; o.x = pk2(s[0 * 33], s[1 * 33]); o.y = pk2(s[2 * 33], s[3 * 33]); o.z = pk2(s[4 * 33], s[5 * 33]); o.w = pk2(s[6 * 33], s[7 * 33]);
        *(u32x4*)(WT + (size_t)(dstrow + n) * K + k0 + 8 * c) = o; }
    LDS_WAIT();
}

__device__ __forceinline__ void phase0(const Params& p, LAS unsigned char* lds) {
    const int tid = threadIdx.x, lane = tid & 63, wave = tid >> 6;
    const int gw = blockIdx.x * 8 + wave, NGW = gridDim.x * 8;
    u16* WtIn = (u16*)(p.ws + WS_WTIN); u16* WtOut = (u16*)(p.ws + WS_WTOUT);
    {
        LAS float* scr = (LAS float*)(lds + wave * 16384);
        constexpr int I_IN = 16 * 208, I_OUT = 32 * 32;
        for (int it = gw; it < I_IN + I_OUT; it += NGW) {
            if (it < I_IN) { const int kb = it / 208, nb = it % 208; transpose_item(p.w_in, DIN, 1024, src_col(32 * nb), WtIn, 32 * nb, scr, 64 * kb, lane, 64 * kb, nullptr); }
            else { const int r = it - I_IN; const int kb = r / 32, nb = r % 32; transpose_item(p.w_out, 1024, 2048, 32 * nb, WtOut, 32 * nb, scr, 64 * kb, lane, 64 * kb, kb >= 16 ? p.snw - 1024 : nullptr); }
        }
    }
    __syncthreads();
    LAS float* wg = (LAS float*)lds;
    for (int idx = tid; idx < 1024 * 24; idx += NTHR) {
        const int k = idx / 24, gc = idx % 24; const int col = gc < 8 ? 2048 + gc : 6664 + (gc - 8);
        const float v = p.w_in[(size_t)k * DIN + col];
        const int ln = (k & 255) >> 2, e = k & 3, j = k >> 8, c4 = gc >> 2, cm = gc & 3;
        wg[((((j * 4 + e) * 6 + c4) * 64 + ln) << 2) + cm] = v;
    }
    __syncthreads();
    u16* H = (u16*)(p.ws + WS_H); float* G = (float*)(p.ws + WS_G);
    f32x4 nw[4];
#pragma unroll
    for (int j = 0; j < 4; ++j) nw[j] = ((const f32x4*)p.norm_w)[lane + 64 * j];
    f32x4 vn[2][4];
#pragma unroll
    for (int r = 0; r < 2; ++r)
#pragma unroll
        for (int j = 0; j < 4; ++j) vn[r][j] = __builtin_nontemporal_load((const f32x4*)(p.x + (size_t)(2 * gw + r) * DM) + lane + 64 * j);
    for (int pr = gw; pr < T / 2; pr += NGW) {
        f32x4 v[2][4];
#pragma unroll
        for (int r = 0; r < 2; ++r)
#pragma unroll
            for (int j = 0; j < 4; ++j) v[r][j] = vn[r][j];
        { const int prn = (pr + NGW < T / 2) ? pr + NGW : pr;
#pragma unroll
          for (int r = 0; r < 2; ++r)
#pragma unroll
            for (int j = 0; j < 4; ++j) vn[r][j] = __builtin_nontemporal_load((const f32x4*)(p.x + (size_t)(2 * prn + r) * DM) + lane + 64 * j); }
#pragma unroll
        for (int r = 0; r < 2; ++r) {
            float s = 0.f;
#pragma unroll
            for (int j = 0; j < 4; ++j) s += (v[r][j].x * v[r][j].x + v[r][j].y * v[r][j].y) + (v[r][j].z * v[r][j].z + v[r][j].w * v[r][j].w);
            const float rstd = rsqrtf(wave_sum(s) * (1.f / DM) + EPS);
            u32x2* o8 = (u32x2*)(H + (size_t)(2 * pr + r) * DM) + lane;
#pragma unroll
            for (int j = 0; j < 4; ++j) { v[r][j] = v[r][j] * rstd * nw[j]; u32x2 o; o.x = pk2(v[r][j].x, v[r][j].y); o.y = pk2(v[r][j].z, v[r][j].w); o8[64 * j] = o; }
        }
        f32x2 a2[2][12];
#pragma unroll
        for (int i = 0; i < 12; ++i) { a2[0][i] = (f32x2){0.f, 0.f}; a2[1][i] = (f32x2){0.f, 0.f}; }
#pragma unroll
        for (int j = 0; j < 4; ++j)
#pragma unroll
            for (int e = 0; e < 4; ++e) {
                asm volatile("" ::: "memory");
#pragma unroll
                for (int c4 = 0; c4 < 6; ++c4) {
                    const f32x4 w = *(const LAS f32x4*)(wg + ((((j * 4 + e) * 6 + c4) * 64 + lane) << 2));
                    const f32x2 wlo = {w.x, w.y}, whi = {w.z, w.w};
                    const f32x2 h0 = {v[0][j][e], v[0][j][e]}, h1 = {v[1][j][e], v[1][j][e]};
                    a2[0][c4 * 2] = __builtin_elementwise_fma(h0, wlo, a2[0][c4 * 2]); a2[0][c4 * 2 + 1] = __builtin_elementwise_fma(h0, whi, a2[0][c4 * 2 + 1]);
                    a2[1][c4 * 2] = __builtin_elementwise_fma(h1, wlo, a2[1][c4 * 2]); a2[1][c4 * 2 + 1] = __builtin_elementwise_fma(h1, whi, a2[1][c4 * 2 + 1]);
                } }
        float a[48];
#pragma unroll
        for (int i = 0; i < 24; ++i) { a[i] = a2[0][i >> 1][i & 1]; a[24 + i] = a2[1][i >> 1][i & 1]; }
        float b24[24], b12[12], b6[6], b3[3];
        { const bool hi = (lane & 32) != 0;
#pragma unroll
          for (int i = 0; i < 24; ++i) { const float snd = hi ? a[i] : a[i + 24], kp = hi ? a[i + 24] : a[i]; b24[i] = kp + __shfl_xor(snd, 32); } }
        { const bool hi = (lane & 16) != 0;
#pragma unroll
          for (int i = 0; i < 12; ++i) { const float snd = hi ? b24[i] : b24[i + 12], kp = hi ? b24[i + 12] : b24[i]; b12[i] = kp + __shfl_xor(snd, 16); } }
        { const bool hi = (lane & 8) != 0;
#pragma unroll
          for (int i = 0; i < 6; ++i) { const float snd = hi ? b12[i] : b12[i + 6], kp = hi ? b12[i + 6] : b12[i]; b6[i] = kp + __shfl_xor(snd, 8); } }
        { const bool hi = (lane & 4) != 0;
#pragma unroll
          for (int i = 0; i < 3; ++i) { const float snd = hi ? b6[i] : b6[i + 3], kp = hi ? b6[i + 3] : b6[i]; b3[i] = kp + __shfl_xor(snd, 4); } }
#pragma unroll
        for (int i = 0; i < 3; ++i) { b3[i] += __shfl_xor(b3[i], 2); b3[i] += __shfl_xor(b3[i], 1); }
        if ((lane & 3) == 0) {
            const int base = ((lane >> 5) & 1) * 24 + ((lane >> 4) & 1) * 12 + ((lane >> 3) & 1) * 6 + ((lane >> 2) & 1) * 3;
#pragma unroll
            for (int i = 0; i < 3; ++i) { const int idx = base + i; const int r = idx / 24, gc = idx % 24; G[(size_t)(2 * pr + r) * NGT + gc] = b3[i]; }
        }
    }
}

__device__ __forceinline__ float scan128_sum(float v, LAS float* s_tot) {
    const int lane = threadIdx.x & 63;
#pragma unroll
    for (int o = 1; o < 64; o <<= 1) { const float t = __shfl_up(v, o); if (lane >= o) v += t; }
    if (threadIdx.x == 63) *s_tot = v;
    __syncthreads();
    if (threadIdx.x >= 64 && threadIdx.x < 128) v += *s_tot;
    return v;
}
__device__ __forceinline__ float scan128_max(float v, LAS float* s_tot) {
    const int lane = threadIdx.x & 63;
#pragma unroll
    for (int o = 1; o < 64; o <<= 1) { const float t = __shfl_up(v, o); if (lane >= o) v = fmaxf(v, t); }
    if (threadIdx.x == 63) *s_tot = v;
    __syncthreads();
    if (threadIdx.x >= 64 && threadIdx.x < 128) v = fmaxf(v, *s_tot);
    return v;
}
__device__ __forceinline__ void mlstm_gates(float ipr, float fpr, LAS float* s_li, LAS float* s_lf, LAS float* s_b) {
    const int tid = threadIdx.x;
    float lf = 0.f;
    if (tid < CL) {
        const float fc = softcap(fpr);
        s_li[tid] = softcap(ipr);
        lf = fminf(fc, 0.f) - log1pf(expf(-fabsf(fc)));
    }
    const float b = scan128_sum(lf, s_lf);
    if (tid < CL) s_b[tid] = b;
    __syncthreads();
}
__device__ __forceinline__ void ssd_gates(const Params& p, int t0, int g, LAS float* s_dt, LAS float* s_ac, LAS float* s_tmp) {
    const int tid = threadIdx.x, lane = tid & 63, hh = tid >> 6, head = g * 8 + hh; const float* G = (const float*)(p.ws + WS_G);
    const float g0 = G[(size_t)(t0 + lane) * NGT + 8 + head], g1 = G[(size_t)(t0 + lane + 64) * NGT + 8 + head];
    const float db = p.dt_bias[head], A = -expf(p.a_log[head]);
    float carry = 0.f;
#pragma unroll
    for (int hf = 0; hf < 2; ++hf) { const int s = lane + 64 * hf;
        const float dtv = softplusf((hf ? g1 : g0) + db);
        float v = dtv * A;
#pragma unroll
        for (int o = 1; o < 64; o <<= 1) { const float t = __shfl_up(v, o); if (lane >= o) v += t; }
        v += carry; carry = __shfl(v, 63);
        s_dt[hh * 128 + s] = dtv; s_ac[hh * 128 + s] = v; }
    __syncthreads();
}
struct ConvW { f32x4 w[8]; float b[8]; };
__device__ __forceinline__ void conv_load(const Params& p, int ch, ConvW& cw) {
#pragma unroll
    for (int i = 0; i < 8; ++i) { cw.w[i] = ((const f32x4*)p.conv_w)[ch + i]; cw.b[i] = p.conv_b[ch + i]; }
}
__device__ __forceinline__ void conv8(const u16* P, const ConvW& cw, int t, int tl, int ch, float* out) {
    u32x4 v[4];
#pragma unroll
    for (int w = 0; w < 4; ++w) { const int d = 3 - w, dd = (tl >= d) ? d : 0; v[w] = *(const u32x4*)(P + (size_t)(t - dd) * LDP + PX + ch); }
    float acc[8];
#pragma unroll
    for (int i = 0; i < 8; ++i) acc[i] = cw.b[i];
#pragma unroll
    for (int w = 0; w < 4; ++w) { const float m = (tl >= 3 - w) ? 1.f : 0.f; float f[8]; unpack8(v[w], f);
#pragma unroll
        for (int i = 0; i < 8; ++i) acc[i] += f[i] * (cw.w[i][w] * m); }
#pragma unroll
    for (int i = 0; i < 8; ++i) out[i] = siluf(acc[i]);
}


__device__ __forceinline__ void conv_roll_load(const u16* P, int t0, int tl0, int s0, int ch, u32x4* raw) {
#pragma unroll
    for (int k = 0; k < 11; ++k) { const int tl = tl0 + s0 - 3 + k; const int rr = tl >= 0 ? t0 + s0 - 3 + k : t0; raw[k] = *(const u32x4*)(P + (size_t)rr * LDP + PX + ch); }
}
__device__ __forceinline__ void conv_roll_row(const u32x4* raw, const ConvW& cw, int j, float m0, float* acc) {
#pragma unroll
    for (int e = 0; e < 8; ++e) acc[e] = cw.b[e];
#pragma unroll
    for (int w = 0; w < 4; ++w) { const float mm = (j + w < 3) ? m0 : 1.f; float f[8]; unpack8(raw[j + w], f);
#pragma unroll
        for (int e = 0; e < 8; ++e) acc[e] += f[e] * (cw.w[e][w] * mm); }
#pragma unroll
    for (int e = 0; e < 8; ++e) acc[e] = siluf(acc[e]);
}

constexpr int LP = 136;
struct M2Pre { float ipr, fpr; u32x4 kv[4], vv[8]; };
__device__ __forceinline__ void m2_load(const Params& p, int item, M2Pre& r) {
    const int tid = threadIdx.x, h = item & 3, t0 = (item >> 2) * CL, ss = tid >> 2, part = tid & 3;
    const u16* P = (const u16*)(p.ws + WS_P); const float* G = (const float*)(p.ws + WS_G);
    r.ipr = 0.f; r.fpr = 0.f;
    if (tid < CL) { r.ipr = G[(size_t)(t0 + tid) * NGT + h]; r.fpr = G[(size_t)(t0 + tid) * NGT + 4 + h]; }
    const u16* kr = P + (size_t)(t0 + ss) * LDP + PK + h * 128 + part * 32;
    const u16* vr = P + (size_t)(t0 + ss) * LDP + PV + h * 256 + part * 64;
#pragma unroll
    for (int c = 0; c < 4; ++c) r.kv[c] = *(const u32x4*)(kr + c * 8);
#pragma unroll
    for (int c = 0; c < 8; ++c) r.vv[c] = *(const u32x4*)(vr + c * 8);
}
__device__ __forceinline__ void phase2_mlstm(const Params& p, LAS unsigned char* lds, int item, M2Pre& pre, int next_item) {
    const int tid = threadIdx.x, lane = tid & 63, wave = tid >> 6;
    const int h = item & 3, bc = item >> 2, t0 = bc * CL;
    LAS u16* KT = (LAS u16*)lds;
    LAS u16* VT = (LAS u16*)(lds + 34816);
    LAS float* sm = (LAS float*)(lds + 34816 + 67584);
    LAS float *s_li = sm, *s_lf = sm + 128, *s_b = sm + 256, *s_w = sm + 384;
    const float bi_h = p.b_i[h], bf_h = p.b_f[h];
    const int ss = tid >> 2, part = tid & 3;
    const float ipr = pre.ipr, fpr = pre.fpr;
    float li = 0.f, lf = 0.f;
    if (tid < CL) { const float fc = softcap(fpr + bf_h); li = softcap(ipr + bi_h); lf = fminf(fc, 0.f) - log1pf(expf(-fabsf(fc))); }
    const float bcum = scan128_sum(lf, s_lf);
    float uv = -3.0e38f;
    if (tid < CL) { uv = li - bcum; ((float*)(p.ws + WS_LU))[(size_t)item * 128 + tid] = uv; ((float*)(p.ws + WS_LB))[(size_t)item * 128 + tid] = bcum; }
    float um = uv;
#pragma unroll
    for (int o = 1; o < 64; o <<= 1) um = fmaxf(um, __shfl_xor(um, o));
    if (lane == 0 && wave < 2) s_li[wave] = um;
    if (tid < CL) s_w[tid] = uv;
    __syncthreads();
    const float umax = fmaxf(s_li[0], s_li[1]);
    if (tid == CL - 1) { ((float*)(p.ws + WS_MBL))[item] = bcum; ((float*)(p.ws + WS_MGM))[item] = bcum + umax; }
    (void)s_b;
    {
        const float w = expf(s_w[ss] - umax);
#pragma unroll
        for (int c = 0; c < 4; ++c) { float f[8]; unpack8(pre.kv[c], f);
            u32x4 o; o.x = pk2(f[0] * w, f[1] * w); o.y = pk2(f[2] * w, f[3] * w); o.z = pk2(f[4] * w, f[5] * w); o.w = pk2(f[6] * w, f[7] * w);
            *(LAS u32x4*)(KT + ss * LP + part * 32 + c * 8) = o; }
#pragma unroll
        for (int c = 0; c < 8; ++c) *(LAS u32x4*)(VT + ss * 264 + part * 64 + c * 8) = pre.vv[c];
    }
    m2_load(p, next_item, pre);
    __syncthreads();
    {
        f32x4 nacc = {0.f, 0.f, 0.f, 0.f};
        const bf16x8 ones = {(short)0x3F80, (short)0x3F80, (short)0x3F80, (short)0x3F80, (short)0x3F80, (short)0x3F80, (short)0x3F80, (short)0x3F80};
#pragma unroll
        for (int ks = 0; ks < 4; ++ks) nacc = __builtin_amdgcn_mfma_f32_16x16x32_bf16(ones, frag_tr(KT, LP, ks * 32, wave * 16, lane), nacc, 0, 0, 0);
        if ((lane >> 4) == 0) ((float*)(p.ws + WS_NLOC))[(size_t)item * 128 + wave * 16 + (lane & 15)] = nacc[0];
    }
    f32x4 acc[8][2];
#pragma unroll
    for (int m = 0; m < 8; ++m)
#pragma unroll
        for (int n = 0; n < 2; ++n) acc[m][n] = (f32x4){0.f, 0.f, 0.f, 0.f};
    mma_lds_tt<8, 2, 4>(acc, KT, LP, VT + wave * 32, 264, lane);
    u16* CS = (u16*)p.out + (size_t)item * 32768;
    const int r = lane & 15, q = lane >> 4;
    {
        u16* dst = CS + (wave * 32 + (q & 1) * 16 + r) * 128 + (q >> 1) * 8;
#pragma unroll
        for (int m = 0; m < 8; ++m) {
            unsigned x0 = pk2(acc[m][0][0], acc[m][0][1]), x1 = pk2(acc[m][0][2], acc[m][0][3]);
            unsigned y0 = pk2(acc[m][1][0], acc[m][1][1]), y1 = pk2(acc[m][1][2], acc[m][1][3]);
            auto s0 = __builtin_amdgcn_permlane16_swap(x0, y0, false, false); x0 = s0[0]; y0 = s0[1];
            auto s1 = __builtin_amdgcn_permlane16_swap(x1, y1, false, false); x1 = s1[0]; y1 = s1[1];
            const u32x4 o = {x0, x1, y0, y1};
            *(u32x4*)(dst + m * 16) = o;
        }
    }
    __syncthreads();
}

__device__ __forceinline__ void phase2_ssd(const Params& p, LAS unsigned char* lds, int item) {
    const int tid = threadIdx.x, lane = tid & 63, wave = tid >> 6;
    const int g = item & 1, bc = item >> 1, t0 = bc * CL, tl0 = (bc & (NCH - 1)) * CL;
    const u16* P = (const u16*)(p.ws + WS_P); u16* XC = (u16*)(p.ws + WS_H);
    LAS u16* BN = (LAS u16*)lds;
    LAS u16* XD = (LAS u16*)(lds + 34816);
    LAS float* sm = (LAS float*)(lds + 34816 + 67584);
    LAS float *s_dt = sm, *s_ac = sm + 1024;
    const int cg = tid & 31, s0 = (tid >> 5) * 8;
    u32x4 raw[11];
#define SSD2_LOAD(half) do { _Pragma("unroll") for (int k = 0; k < 11; ++k) { const int tl = tl0 + s0 - 3 + k; const int rr = tl >= 0 ? t0 + s0 - 3 + k : t0; \
        raw[k] = *(const u32x4*)(P + (size_t)rr * LDP + PX + g * 512 + (half) * 256 + cg * 8); } } while (0)
    SSD2_LOAD(0);
    ssd_gates(p, t0, g, s_dt, s_ac, sm + 2048);
    { float* sg = (float*)(p.ws + WS_SG) + (size_t)item * 2048; sg[tid] = s_dt[tid]; sg[tid + 512] = s_dt[tid + 512]; sg[1024 + tid] = s_ac[tid]; sg[1536 + tid] = s_ac[tid + 512]; }
    if (tid < 8) ((float*)(p.ws + WS_SDEC))[item * 8 + tid] = expf(s_ac[tid * 128 + 127]);
    if (tid < 256) {
        const int cgp = tid & 15, sb = (tid >> 4) * 8, chb = 1024 + g * 128 + cgp * 8;
        u32x4 rawb[11]; conv_roll_load(P, t0, tl0, sb, chb, rawb);
        ConvW cw; conv_load(p, chb, cw);
        const float m0 = (tl0 + sb - 3 >= 0) ? 1.f : 0.f;
#pragma unroll
        for (int j = 0; j < 8; ++j) { float f[8]; conv_roll_row(rawb, cw, j, m0, f);
            u32x4 o; o.x = pk2(f[0], f[1]); o.y = pk2(f[2], f[3]); o.z = pk2(f[4], f[5]); o.w = pk2(f[6], f[7]); *(LAS u32x4*)(BN + (sb + j) * LP + cgp * 8) = o; }
    }
    u16* HS = (u16*)p.out + (size_t)1024 * 32768;
    const int r = lane & 15, q = lane >> 4;
#pragma unroll 1
    for (int hb = 0; hb < 2; ++hb) {
        {
            const int ch = g * 512 + hb * 256 + cg * 8, hh = hb * 4 + (cg >> 3);
            ConvW cw; conv_load(p, ch, cw);
            const float alast = s_ac[hh * 128 + 127];
            float m0 = (tl0 + s0 - 3 >= 0) ? 1.f : 0.f;
#pragma unroll
            for (int j = 0; j < 8; ++j) {
                float acc[8];
#pragma unroll
                for (int e = 0; e < 8; ++e) acc[e] = cw.b[e];
#pragma unroll
                for (int w = 0; w < 4; ++w) { const float mm = (j + w < 3) ? m0 : 1.f; float f[8]; unpack8(raw[j + w], f);
#pragma unroll
                    for (int e = 0; e < 8; ++e) acc[e] += f[e] * (cw.w[e][w] * mm); }
#pragma unroll
                for (int e = 0; e < 8; ++e) acc[e] = siluf(acc[e]);
                const int sr = s0 + j; const float sc = s_dt[hh * 128 + sr] * expf(alast - s_ac[hh * 128 + sr]);
                u32x4 o; o.x = pk2(acc[0], acc[1]); o.y = pk2(acc[2], acc[3]); o.z = pk2(acc[4], acc[5]); o.w = pk2(acc[6], acc[7]);
                *(u32x4*)(XC + (size_t)(t0 + sr) * 1024 + ch) = o;
                o.x = pk2(acc[0] * sc, acc[1] * sc); o.y = pk2(acc[2] * sc, acc[3] * sc); o.z = pk2(acc[4] * sc, acc[5] * sc); o.w = pk2(acc[6] * sc, acc[7] * sc);
                *(LAS u32x4*)(XD + sr * 264 + cg * 8) = o;
            }
        }
        if (hb == 0) SSD2_LOAD(1);
        __syncthreads();
        const int h4 = wave >> 1, nh = wave & 1, head = g * 8 + hb * 4 + h4;
        f32x4 acc[4][4];
#pragma unroll
        for (int m = 0; m < 4; ++m)
#pragma unroll
            for (int n = 0; n < 4; ++n) acc[m][n] = (f32x4){0.f, 0.f, 0.f, 0.f};
        mma_lds_tt<4, 4, 4>(acc, BN + nh * 64, LP, XD + h4 * 64, 264, lane);
        u16* dst = HS + ((size_t)bc * 16 + head) * 8192;
#pragma unroll
        for (int m = 0; m < 4; ++m)
#pragma unroll
            for (int n2 = 0; n2 < 4; n2 += 2) {
                unsigned x0 = pk2(acc[m][n2][0], acc[m][n2][1]), x1 = pk2(acc[m][n2][2], acc[m][n2][3]);
                unsigned y0 = pk2(acc[m][n2 + 1][0], acc[m][n2 + 1][1]), y1 = pk2(acc[m][n2 + 1][2], acc[m][n2 + 1][3]);
                auto s0 = __builtin_amdgcn_permlane16_swap(x0, y0, false, false); x0 = s0[0]; y0 = s0[1];
                auto s1 = __builtin_amdgcn_permlane16_swap(x1, y1, false, false); x1 = s1[0]; y1 = s1[1];
                const u32x4 o = {x0, x1, y0, y1};
                *(u32x4*)(dst + ((n2 + (q & 1)) * 16 + r) * 128 + nh * 64 + m * 16 + (q >> 1) * 8) = o; }
        __syncthreads();
    }
#undef SSD2_LOAD
}

__device__ __forceinline__ void phase3(const Params& p) {
    const int gtid = blockIdx.x * NTHR + threadIdx.x, nthr = gridDim.x * NTHR;
    for (int w = gtid; w < 131072; w += nthr) {
        if (w < 65536) {
            const int bh = w >> 12, e8 = w & 4095, b = bh >> 2, h = bh & 3;
            u16* CS = (u16*)p.out; const float* MBL = (const float*)(p.ws + WS_MBL); const float* MGM = (const float*)(p.ws + WS_MGM);
            float* MPREV = (float*)(p.ws + WS_MPREV); float* NL = (float*)(p.ws + WS_NLOC);
            float C[8]; float m = 0.f;
#pragma unroll
            for (int i = 0; i < 8; ++i) C[i] = 0.f;
            u32x4 vn[8]; float an[8], gn[8], nn[8]; float nv = 0.f; const int en = e8 & 127;
#define P3_LOAD(c0_) do { _Pragma("unroll") for (int j = 0; j < 8; ++j) { const int it_ = (b * NCH + (c0_) + j) * 4 + h; vn[j] = *(const u32x4*)(CS + (size_t)it_ * 32768 + e8 * 8); an[j] = MBL[it_]; gn[j] = MGM[it_]; nn[j] = NL[(size_t)it_ * 128 + en]; } } while (0)
            P3_LOAD(0);
#pragma unroll 1
            for (int c0 = 0; c0 < NCH; c0 += 8) {
                u32x4 v[8]; float av[8], gv[8], nl[8];
#pragma unroll
                for (int j = 0; j < 8; ++j) { v[j] = vn[j]; av[j] = an[j]; gv[j] = gn[j]; nl[j] = nn[j]; }
                if (c0 + 8 < NCH) P3_LOAD(c0 + 8);
#pragma unroll
                for (int j = 0; j < 8; ++j) {
                    const int item = (b * NCH + c0 + j) * 4 + h;
                    const float a = av[j], gm = gv[j];
                    const float mn = fmaxf(a + m, gm), so = __expf(a + m - mn), sl = __expf(gm - mn);
                    float f[8]; unpack8(v[j], f);
                    u32x4 o; o.x = pk2(C[0], C[1]); o.y = pk2(C[2], C[3]); o.z = pk2(C[4], C[5]); o.w = pk2(C[6], C[7]);
                    *(u32x4*)(CS + (size_t)item * 32768 + e8 * 8) = o;
#pragma unroll
                    for (int i = 0; i < 8; ++i) C[i] = so * C[i] + sl * f[i];
                    if (e8 < 128) { NL[(size_t)item * 128 + e8] = nv; if (e8 == 0) MPREV[item] = m; }
                    nv = so * nv + sl * nl[j];
                    m = mn;
                }
            }
#undef P3_LOAD
        } else {
            const int idx = w - 65536, bhd = idx >> 10, e8 = idx & 1023, b = bhd >> 4, head = bhd & 15;
            u16* HS = (u16*)p.out + (size_t)1024 * 32768; const float* SD = (const float*)(p.ws + WS_SDEC);
            float hs[8];
#pragma unroll
            for (int i = 0; i < 8; ++i) hs[i] = 0.f;
            u32x4 vn[8]; float dn[8];
#define P3_LOAD(c0_) do { _Pragma("unroll") for (int j = 0; j < 8; ++j) { const int bc_ = b * NCH + (c0_) + j; vn[j] = *(const u32x4*)(HS + ((size_t)bc_ * 16 + head) * 8192 + e8 * 8); dn[j] = SD[(bc_ * 2 + (head >> 3)) * 8 + (head & 7)]; } } while (0)
            P3_LOAD(0);
#pragma unroll 1
            for (int c0 = 0; c0 < NCH; c0 += 8) {
                u32x4 v[8]; float dv[8];
#pragma unroll
                for (int j = 0; j < 8; ++j) { v[j] = vn[j]; dv[j] = dn[j]; }
                if (c0 + 8 < NCH) P3_LOAD(c0 + 8);
#pragma unroll
                for (int j = 0; j < 8; ++j) {
                    const int bc = b * NCH + c0 + j;
                    float f[8]; unpack8(v[j], f);
                    u32x4 o; o.x = pk2(hs[0], hs[1]); o.y = pk2(hs[2], hs[3]); o.z = pk2(hs[4], hs[5]); o.w = pk2(hs[6], hs[7]);
                    *(u32x4*)(HS + ((size_t)bc * 16 + head) * 8192 + e8 * 8) = o;
#pragma unroll
                    for (int i = 0; i < 8; ++i) hs[i] = dv[j] * hs[i] + f[i];
                }
            }
#undef P3_LOAD
        }
    }
}

struct M4Pre { float ipr, fpr, npv, mprev; u32x4 qv[4], kv[4]; };
__device__ __forceinline__ void m4_load(const Params& p, int item, M4Pre& r) {
    const int tid = threadIdx.x, h = item & 3, t0 = (item >> 2) * CL, ss = tid >> 2, part = tid & 3;
    const u16* prow = (const u16*)(p.ws + WS_P) + (size_t)(t0 + ss) * LDP; const float* G = (const float*)(p.ws + WS_G);
    r.ipr = 0.f; r.fpr = 0.f; r.npv = 0.f;
    if (tid < CL) { r.ipr = ((const float*)(p.ws + WS_LU))[(size_t)item * 128 + tid]; r.fpr = ((const float*)(p.ws + WS_LB))[(size_t)item * 128 + tid]; r.npv = ((const float*)(p.ws + WS_NLOC))[(size_t)item * 128 + tid]; }
    (void)G;
    r.mprev = ((const float*)(p.ws + WS_MPREV))[item];
#pragma unroll
    for (int c = 0; c < 4; ++c) { r.qv[c] = *(const u32x4*)(prow + PQ + h * 128 + part * 32 + c * 8); r.kv[c] = *(const u32x4*)(prow + PK + h * 128 + part * 32 + c * 8); }
}
__device__ __forceinline__ void phase4_mlstm(const Params& p, LAS unsigned char* lds, int item, M4Pre& pre, int next_item, bool first) {
    const int tid = threadIdx.x, lane = tid & 63, wave = tid >> 6;
    const int h = item & 3, bc = item >> 2, t0 = bc * CL;
    u16* P = (u16*)(p.ws + WS_P); const float* G = (const float*)(p.ws + WS_G);
    LAS u16* Q = (LAS u16*)lds;
    LAS u16* KS = (LAS u16*)(lds + 34816);
    LAS u16* VT = (LAS u16*)(lds + 69632);
    LAS u16* CP = (LAS u16*)(lds + 104448);
    LAS float* HB = (LAS float*)lds;
    LAS float* sm = (LAS float*)(lds + 139264);
    LAS float *s_li = sm, *s_lf = sm + 128, *s_b = sm + 256, *s_u = sm + 384, *s_M = sm + 512, *s_np = sm + 768;
    const int ss = tid >> 2, part = tid & 3;
    const u16* CS = (const u16*)p.out + (size_t)item * 32768;
    const u16* prow = P + (size_t)(t0 + ss) * LDP;
    const float ipr = pre.ipr, fpr = pre.fpr, npv = pre.npv, mprev = pre.mprev;
    if (first) { if (tid < 256) sm[896 + tid] = p.mnw[h * 256 + tid]; }
    float uv = -3.0e38f;
    if (tid < CL) { uv = ipr; s_u[tid] = uv; s_b[tid] = fpr; s_np[tid] = npv; }
    (void)s_li;
#pragma unroll
    for (int c = 0; c < 4; ++c) { *(LAS u32x4*)(Q + ss * LP + part * 32 + c * 8) = pre.qv[c]; *(LAS u32x4*)(KS + ss * LP + part * 32 + c * 8) = pre.kv[c]; }
    u32x4 vv[4], cv[4];
#pragma unroll
    for (int c = 0; c < 4; ++c) { vv[c] = *(const u32x4*)(prow + PV + h * 256 + part * 32 + c * 8); cv[c] = *(const u32x4*)(CS + (size_t)ss * 128 + part * 32 + c * 8); }
    const float pm = scan128_max(uv, s_lf);
    if (tid < CL) s_M[tid] = fmaxf(mprev, pm);
    const int r = lane & 15, q = lane >> 4;
    f32x4 qnacc = {0.f, 0.f, 0.f, 0.f};
#pragma unroll
    for (int ks = 0; ks < 4; ++ks) {
        const f32x4 n0 = *(const LAS f32x4*)(s_np + ks * 32 + q * 8), n1 = *(const LAS f32x4*)(s_np + ks * 32 + q * 8 + 4);
        const u32x4 nb = {pk2(n0.x, n0.y), pk2(n0.z, n0.w), pk2(n1.x, n1.y), pk2(n1.z, n1.w)};
        qnacc = __builtin_amdgcn_mfma_f32_16x16x32_bf16(*(const LAS bf16x8*)(Q + (wave * 16 + r) * LP + ks * 32 + q * 8), __builtin_bit_cast(bf16x8, nb), qnacc, 0, 0, 0);
    }
    f32x4 sacc[1][8];
#pragma unroll
    for (int n = 0; n < 8; ++n) sacc[0][n] = (f32x4){0.f, 0.f, 0.f, 0.f};
    mma_lds<1, 8, 4>(sacc, Q + wave * 16 * LP, LP, KS, LP, lane);
    __syncthreads();
    float den[4] = {0.f, 0.f, 0.f, 0.f};
    {
        float Mr[4];
#pragma unroll
        for (int i = 0; i < 4; ++i) Mr[i] = s_M[wave * 16 + q * 4 + i];
#pragma unroll
        for (int n = 0; n < 8; ++n) { const int s = n * 16 + r; const float us = s_u[s];
#pragma unroll
            for (int i = 0; i < 4; ++i) { const int j = wave * 16 + q * 4 + i; float wgt = __expf(fminf(us - Mr[i], 0.f)); wgt = (s <= j) ? wgt : 0.f; const float sp = sacc[0][n][i] * wgt; den[i] += sp;
                KS[j * LP + s] = f2bf(sp); } }
    }
#pragma unroll
    for (int i = 0; i < 4; ++i) { den[i] += __shfl_xor(den[i], 1); den[i] += __shfl_xor(den[i], 2); den[i] += __shfl_xor(den[i], 4); den[i] += __shfl_xor(den[i], 8); }
    float isc[4], Mj[4], bj[4], qn[4];
#pragma unroll
    for (int i = 0; i < 4; ++i) { const int j = wave * 16 + q * 4 + i; Mj[i] = s_M[j]; bj[i] = s_b[j]; qn[i] = qnacc[i]; isc[i] = __expf(mprev - Mj[i]); }
#pragma unroll
    for (int c = 0; c < 4; ++c) { *(LAS u32x4*)(VT + ss * LP + part * 32 + c * 8) = vv[c]; *(LAS u32x4*)(CP + ss * LP + part * 32 + c * 8) = cv[c]; }
#pragma unroll
    for (int c = 0; c < 4; ++c) { vv[c] = *(const u32x4*)(prow + PV + h * 256 + 128 + part * 32 + c * 8); cv[c] = *(const u32x4*)(CS + (size_t)(128 + ss) * 128 + part * 32 + c * 8); }
    __syncthreads();
    f32x4 acc[2][1][8];
#pragma unroll
    for (int n = 0; n < 8; ++n) acc[0][0][n] = (f32x4){0.f, 0.f, 0.f, 0.f};
    mma_lds<1, 8, 4>(acc[0], Q + wave * 16 * LP, LP, CP, LP, lane);
#pragma unroll
    for (int n = 0; n < 8; ++n)
#pragma unroll
        for (int i = 0; i < 4; ++i) acc[0][0][n][i] *= isc[i];
    mma_lds_bt<1, 8, 4>(acc[0], KS + wave * 16 * LP, LP, VT, LP, lane);
    __syncthreads();
#pragma unroll
    for (int c = 0; c < 4; ++c) { *(LAS u32x4*)(VT + ss * LP + part * 32 + c * 8) = vv[c]; *(LAS u32x4*)(CP + ss * LP + part * 32 + c * 8) = cv[c]; }
    u16* obase = P + (size_t)(t0 + (tid >> 5)) * LDP + PO + h * 256 + (tid & 31) * 8; const u16* zbase = obase + (PZM - PO);
    u32x4 zvv[8];
#pragma unroll
    for (int it = 0; it < 8; ++it) zvv[it] = *(const u32x4*)(zbase + (size_t)(16 * it) * LDP);
    __syncthreads();
#pragma unroll
    for (int n = 0; n < 8; ++n) acc[1][0][n] = (f32x4){0.f, 0.f, 0.f, 0.f};
    mma_lds<1, 8, 4>(acc[1], Q + wave * 16 * LP, LP, CP, LP, lane);
#pragma unroll
    for (int n = 0; n < 8; ++n)
#pragma unroll
        for (int i = 0; i < 4; ++i) acc[1][0][n][i] *= isc[i];
    mma_lds_bt<1, 8, 4>(acc[1], KS + wave * 16 * LP, LP, VT, LP, lane);
    const float scale = 0.08838834764831845f;
    float fac[4];
#pragma unroll
    for (int i = 0; i < 4; ++i) { const float dt = scale * (den[i] + isc[i] * qn[i]); const float dn = fmaxf(fabsf(dt), __expf(-(bj[i] + Mj[i]))); fac[i] = scale / dn; }
    __syncthreads();
#pragma unroll
    for (int hf = 0; hf < 2; ++hf)
#pragma unroll
        for (int n = 0; n < 8; ++n)
#pragma unroll
            for (int i = 0; i < 4; ++i) HB[(wave * 16 + q * 4 + i) * 260 + hf * 128 + n * 16 + r] = acc[hf][0][n][i] * fac[i];
    __syncthreads();
    m4_load(p, next_item, pre);
    {
        const int j = ss;
        float sq = 0.f;
#pragma unroll
        for (int it = 0; it < 8; ++it) { const int vd = (it * 4 + part) * 8; const f32x4 a = *(const LAS f32x4*)(HB + j * 260 + vd), b = *(const LAS f32x4*)(HB + j * 260 + vd + 4);
            sq += (a.x * a.x + a.y * a.y) + (a.z * a.z + a.w * a.w) + (b.x * b.x + b.y * b.y) + (b.z * b.z + b.w * b.w); }
        sq += __shfl_xor(sq, 1); sq += __shfl_xor(sq, 2);
        if (part == 0) s_u[j] = rsqrtf(sq * (1.f / 256.f) + EPS);
    }
    __syncthreads();
    {
        const int vd = (tid & 31) * 8;
        const f32x4 w0 = *(const LAS f32x4*)(sm + 896 + vd), w1 = *(const LAS f32x4*)(sm + 896 + vd + 4);
        const float wv[8] = {w0.x, w0.y, w0.z, w0.w, w1.x, w1.y, w1.z, w1.w};
#pragma unroll
        for (int it = 0; it < 8; ++it) { const int j = (tid >> 5) + 16 * it; const float rstd = s_u[j];
            const f32x4 a = *(const LAS f32x4*)(HB + j * 260 + vd), b = *(const LAS f32x4*)(HB + j * 260 + vd + 4);
            const float hv[8] = {a.x, a.y, a.z, a.w, b.x, b.y, b.z, b.w};
            float zf[8]; unpack8(zvv[it], zf);
            float y[8];
#pragma unroll
            for (int e = 0; e < 8; ++e) y[e] = hv[e] * rstd * wv[e] * zf[e];
            u32x4 o; o.x = pk2(y[0], y[1]); o.y = pk2(y[2], y[3]); o.z = pk2(y[4], y[5]); o.w = pk2(y[6], y[7]);
            *(u32x4*)(obase + (size_t)(16 * it) * LDP) = o; }
    }
    __syncthreads();
}

__device__ __forceinline__ void phase4_ssd(const Params& p, LAS unsigned char* lds, int item) {
    const int tid = threadIdx.x, lane = tid & 63, wave = tid >> 6;
    const int g = item & 1, bc = item >> 1, t0 = bc * CL, tl0 = (bc & (NCH - 1)) * CL;
    u16* P = (u16*)(p.ws + WS_P); const u16* XC = (const u16*)(p.ws + WS_H);
    LAS u16* CM = (LAS u16*)lds;
    LAS u16* BM = (LAS u16*)(lds + 34816);
#define SSD4_XS(b_) ((LAS u16*)(lds + 34816 + (b_) * 18432))
#define SSD4_ZS(b_) ((LAS u16*)(lds + 71680 + (b_) * 18432))
#define SSD4_HP(b_) ((LAS u16*)(lds + ((b_) ? 132640 : 108544)))
    LAS float* sm = (LAS float*)(lds + 150048);
    LAS float *s_dt = sm, *s_ac = sm + 1024, *s_rs = sm + 2048;
    const u16* HS = (const u16*)p.out + (size_t)1024 * 32768;
    u32x4 zv[2], xv[2], hv[2];
#define SSD4_LOAD(head_) do { _Pragma("unroll") for (int i = 0; i < 2; ++i) { const int ch = tid + NTHR * i, row = ch >> 3, c8 = ch & 7, pp = ch >> 4, c16 = ch & 15; \
        zv[i] = *(const u32x4*)(P + (size_t)(t0 + row) * LDP + PZS + (head_) * 64 + c8 * 8); \
        xv[i] = *(const u32x4*)(XC + (size_t)(t0 + row) * 1024 + (head_) * 64 + c8 * 8); \
        hv[i] = *(const u32x4*)(HS + ((size_t)bc * 16 + (head_)) * 8192 + pp * 128 + c16 * 8); } } while (0)
    if (tid < 8) s_rs[128 + tid] = p.d_skip[g * 8 + tid];
    { const float* sg = (const float*)(p.ws + WS_SG) + (size_t)item * 2048; const float d0 = sg[tid], d1 = sg[tid + 512], a0 = sg[1024 + tid], a1 = sg[1536 + tid];
      s_dt[tid] = d0; s_dt[tid + 512] = d1; s_ac[tid] = a0; s_ac[tid + 512] = a1; }
    __syncthreads();
    {
        const int mat = tid >> 8, t8 = tid & 255, cgp = t8 & 15, sb = (t8 >> 4) * 8, chb = 1024 + mat * 256 + g * 128 + cgp * 8;
        u32x4 rawb[11]; conv_roll_load(P, t0, tl0, sb, chb, rawb);
        ConvW cw; conv_load(p, chb, cw);
        LAS u16* dstt = mat ? CM : BM; const float m0 = (tl0 + sb - 3 >= 0) ? 1.f : 0.f;
#pragma unroll
        for (int j = 0; j < 8; ++j) { float f[8]; conv_roll_row(rawb, cw, j, m0, f);
            u32x4 o; o.x = pk2(f[0], f[1]); o.y = pk2(f[2], f[3]); o.z = pk2(f[4], f[5]); o.w = pk2(f[6], f[7]); *(LAS u32x4*)(dstt + (sb + j) * LP + cgp * 8) = o; }
    }
    SSD4_LOAD(g * 8);
    __syncthreads();
    const int r = lane & 15, q = lane >> 4;
    const int lcol = wave * 16 + r;
    f32x4 cbT[8][1];
#pragma unroll
    for (int m = 0; m < 8; ++m) cbT[m][0] = (f32x4){0.f, 0.f, 0.f, 0.f};
    mma_lds<8, 1, 4>(cbT, BM, LP, CM + wave * 16 * LP, LP, lane);
    float ssq = 0.f;
    __syncthreads();
#define SSD4_STAGE(b_) do { _Pragma("unroll") for (int i = 0; i < 2; ++i) { const int ch = tid + NTHR * i, row = ch >> 3, c8 = ch & 7, pp = ch >> 4, c16 = ch & 15; \
        *(LAS u32x4*)(SSD4_ZS(b_) + row * 72 + c8 * 8) = zv[i]; *(LAS u32x4*)(SSD4_XS(b_) + row * 72 + c8 * 8) = xv[i]; *(LAS u32x4*)(SSD4_HP(b_) + pp * LP + c16 * 8) = hv[i]; } } while (0)
    SSD4_STAGE(0); SSD4_LOAD(g * 8 + 1);
#pragma unroll 1
    for (int hh = 0; hh < 8; ++hh) {
        const int head = g * 8 + hh, cb_ = hh & 1, nb_ = cb_ ^ 1;
        LAS u16* XS = SSD4_XS(cb_); LAS u16* ZS = SSD4_ZS(cb_); LAS u16* HP = SSD4_HP(cb_);
        bf16x8 mfrag[4];
        {
            const float acl = s_ac[hh * 128 + lcol];
#pragma unroll
            for (int ks = 0; ks < 4; ++ks) {
                unsigned pk[4];
#pragma unroll
                for (int hf = 0; hf < 2; ++hf) { const int m = 2 * ks + hf, sb = 16 * m + 4 * q;
                    const f32x4 a4 = *(const LAS f32x4*)(s_ac + hh * 128 + sb), d4 = *(const LAS f32x4*)(s_dt + hh * 128 + sb);
                    float v[4];
#pragma unroll
                    for (int i = 0; i < 4; ++i) { float t = cbT[m][0][i] * __expf(fminf(acl - a4[i], 0.f)) * d4[i]; v[i] = (sb + i <= lcol) ? t : 0.f; }
                    pk[2 * hf] = pk2(v[0], v[1]); pk[2 * hf + 1] = pk2(v[2], v[3]); }
                const u32x4 u = {pk[0], pk[1], pk[2], pk[3]};
                mfrag[ks] = __builtin_bit_cast(bf16x8, u);
            }
        }
        __syncthreads();
        if (hh > 0) {
#pragma unroll
            for (int i = 0; i < 2; ++i) { const int ch = tid + NTHR * i, row = ch >> 3, c8 = ch & 7; const u32x4 yv = *(const LAS u32x4*)(SSD4_ZS(nb_) + row * 72 + c8 * 8);
                *(u32x4*)(P + (size_t)(t0 + row) * LDP + PZS + (head - 1) * 64 + c8 * 8) = yv; }
        }
        if (hh < 7) { if (nb_) SSD4_STAGE(1); else SSD4_STAGE(0); if (hh < 6) SSD4_LOAD(head + 2); }
        f32x4 ya[4][1];
#pragma unroll
        for (int mt = 0; mt < 4; ++mt) ya[mt][0] = (f32x4){0.f, 0.f, 0.f, 0.f};
        mma_lds<4, 1, 4>(ya, HP, LP, CM + wave * 16 * LP, LP, lane);
        { const float ea = __expf(s_ac[hh * 128 + lcol]);
#pragma unroll
          for (int mt = 0; mt < 4; ++mt) ya[mt][0] *= ea; }
#pragma unroll
        for (int ks = 0; ks < 4; ++ks) {
#pragma unroll
            for (int mt = 0; mt < 4; ++mt) {
                const LAS u16* p0 = XS + (32 * ks + 4 * q + (r >> 2)) * 72 + 16 * mt + (r & 3) * 4;
                const v4i16_t lo = __builtin_amdgcn_ds_read_tr16_b64_v4i16((LAS v4i16_t*)p0);
                const v4i16_t hi = __builtin_amdgcn_ds_read_tr16_b64_v4i16((LAS v4i16_t*)(p0 + 16 * 72));
                const bf16x8 af = __builtin_shufflevector(lo, hi, 0, 1, 2, 3, 4, 5, 6, 7);
                ya[mt][0] = __builtin_amdgcn_mfma_f32_16x16x32_bf16(af, mfrag[ks], ya[mt][0], 0, 0, 0);
            }
        }
        const float dsk = s_rs[128 + hh];
        {
            u32x2 xs4[4], zs4[4];
#pragma unroll
            for (int mt = 0; mt < 4; ++mt) { xs4[mt] = *(const LAS u32x2*)(XS + lcol * 72 + 16 * mt + 4 * q); zs4[mt] = *(const LAS u32x2*)(ZS + lcol * 72 + 16 * mt + 4 * q); }
#pragma unroll
            for (int mt = 0; mt < 4; ++mt) {
                const float xf[4] = {bflo(xs4[mt].x), bfhi(xs4[mt].x), bflo(xs4[mt].y), bfhi(xs4[mt].y)};
                const float zf[4] = {bflo(zs4[mt].x), bfhi(zs4[mt].x), bflo(zs4[mt].y), bfhi(zs4[mt].y)};
                float y[4];
#pragma unroll
                for (int i = 0; i < 4; ++i) { y[i] = (ya[mt][0][i] + dsk * xf[i]) * zf[i]; ssq += y[i] * y[i]; }
                u32x2 o; o.x = pk2(y[0], y[1]); o.y = pk2(y[2], y[3]);
                *(LAS u32x2*)(ZS + lcol * 72 + 16 * mt + 4 * q) = o;
            }
        }
    }
#undef SSD4_LOAD
    ssq += __shfl_xor(ssq, 16); ssq += __shfl_xor(ssq, 32);
    if (q == 0) ((float*)(p.ws + WS_RSG))[2 * (size_t)(t0 + lcol) + g] = rsqrtf(ssq * (1.f / 512.f) + EPS);
    __syncthreads();
#pragma unroll
    for (int i = 0; i < 2; ++i) { const int ch = tid + NTHR * i, row = ch >> 3, c8 = ch & 7; const u32x4 yv = *(const LAS u32x4*)(SSD4_ZS(1) + row * 72 + c8 * 8);
        *(u32x4*)(P + (size_t)(t0 + row) * LDP + PZS + (g * 8 + 7) * 64 + c8 * 8) = yv; }
    __syncthreads();
#undef SSD4_STAGE
#undef SSD4_XS
#undef SSD4_ZS
#undef SSD4_HP
}

__device__ __forceinline__ void phase6(const Params& p) {
    const int lane = threadIdx.x & 63, wave = threadIdx.x >> 6;
    const int gw = blockIdx.x * 8 + wave, NGW = gridDim.x * 8;
    const u16* Z = (const u16*)(p.ws + WS_H);
    f32x4 nw[4];
#pragma unroll
    for (int j = 0; j < 4; ++j) nw[j] = ((const f32x4*)p.fnw)[lane + 64 * j];
    for (int r4 = gw; r4 < T / 4; r4 += NGW) {
        u32x2 zv[4][4]; float s[4]; f32x4 f[4][4];
#pragma unroll
        for (int k = 0; k < 4; ++k)
#pragma unroll
            for (int j = 0; j < 4; ++j) { zv[k][j] = ((const u32x2*)(Z + (size_t)(4 * r4 + k) * DM))[lane + 64 * j]; f[k][j] = __builtin_nontemporal_load((const f32x4*)(p.x + (size_t)(4 * r4 + k) * DM) + lane + 64 * j); }
#pragma unroll
        for (int k = 0; k < 4; ++k) { s[k] = 0.f;
#pragma unroll
            for (int j = 0; j < 4; ++j) { f[k][j] += (f32x4){bflo(zv[k][j].x), bfhi(zv[k][j].x), bflo(zv[k][j].y), bfhi(zv[k][j].y)};
                s[k] += (f[k][j].x * f[k][j].x + f[k][j].y * f[k][j].y) + (f[k][j].z * f[k][j].z + f[k][j].w * f[k][j].w); } }
#pragma unroll
        for (int o = 1; o < 64; o <<= 1) {
#pragma unroll
            for (int k = 0; k < 4; ++k) s[k] += __shfl_xor(s[k], o); }
#pragma unroll
        for (int k = 0; k < 4; ++k) { const float rstd = rsqrtf(s[k] * (1.f / DM) + EPS);
#pragma unroll
            for (int j = 0; j < 4; ++j) ((f32x4*)(p.out + (size_t)(4 * r4 + k) * DM))[lane + 64 * j] = f[k][j] * rstd * nw[j]; }
    }
}

__global__ void __launch_bounds__(NTHR) fwd_kernel(Params p) {
    extern __shared__ __attribute__((aligned(16))) unsigned char lds_raw[];
    LAS unsigned char* lds = (LAS unsigned char*)lds_raw;
    cg::grid_group grid = cg::this_grid();
    const int lo = p.ph_lo, hi = p.ph_hi;
    if (lo < 0) grid.sync();
    volatile LAS unsigned* xbst = (volatile LAS unsigned*)(lds + LDS_BYTES - 16);
    if (threadIdx.x < 4) xbst[threadIdx.x] = 0u;
    __syncthreads();
    XcdBarrier bar = xcd_barrier_post((unsigned*)(p.ws + WS_BAR), xbst);
#ifndef PHMASK
#define PHMASK 127
#endif
#define IN(k) (((PHMASK >> (k)) & 1) && lo <= (k) && (k) < hi)
#define SEAM(k) do { if (IN(k) && IN((k) + 1)) xcd_barrier(bar); } while (0)
#ifndef PROBE
#define PROBE 0
#endif
#define GSYNC() do { if (hi - lo > 1) xcd_barrier(bar); } while (0)
#define PH1() do { pg8::Gemm g{(const u16*)(p.ws + WS_H), (const u16*)(p.ws + WS_WTIN), T, LDP, DM, DM}; pg8::StaticOrder S; S.init(T, LDP, gridDim.x, blockIdx.x); \
        pg8::EpiP E{(u16*)(p.ws + WS_P), LDP, nullptr}; pg8::gemm_phase<pg8::EpiP, pg8::StaticOrder>(lds, g, S, E); } while (0)
#define PH2() do { { M2Pre pre_; if ((int)blockIdx.x < 1024) m2_load(p, blockIdx.x, pre_); for (int it = blockIdx.x; it < 1024; it += gridDim.x) { const int nx_ = it + gridDim.x; phase2_mlstm(p, lds, it, pre_, nx_ < 1024 ? nx_ : it); } } \
        for (int it = blockIdx.x; it < 512; it += gridDim.x) phase2_ssd(p, lds, it); } while (0)
#define PH4() do { { M4Pre pre_; if ((int)blockIdx.x < 1024) m4_load(p, blockIdx.x, pre_); for (int it = blockIdx.x; it < 1024; it += gridDim.x) { const int nx_ = it + gridDim.x; phase4_mlstm(p, lds, it, pre_, nx_ < 1024 ? nx_ : it, it == (int)blockIdx.x || (gridDim.x & 3) != 0); } } \
        for (int it = blockIdx.x; it < 512; it += gridDim.x) phase4_ssd(p, lds, it); } while (0)
#define PH5() do { pg8::Gemm g{(const u16*)(p.ws + WS_P) + PO, (const u16*)(p.ws + WS_WTOUT), T, DM, 2048, LDP}; pg8::StaticOrder S; S.init(T, DM, gridDim.x, blockIdx.x); \
        pg8::EpiOut E{(u16*)(p.ws + WS_H), p.x, DM, (const float*)(p.ws + WS_RSG)}; pg8::gemm_phase<pg8::EpiOut, pg8::StaticOrder>(lds, g, S, E); } while (0)
    if (IN(0)) { phase0(p, lds); if (PROBE == 1) { GSYNC(); phase0(p, lds); } }
    SEAM(0);
    if (IN(1)) { PH1(); if (PROBE == 2) { GSYNC(); PH1(); } }
    SEAM(1);
    if (IN(2)) { PH2(); if (PROBE == 3) { GSYNC(); PH2(); } }
    SEAM(2);
    if (IN(3)) { phase3(p); if (PROBE == 4) { GSYNC(); PH2(); GSYNC(); phase3(p); } }
    SEAM(3);
    if (IN(4)) PH4();
    SEAM(4);
    if (IN(5)) { PH5(); if (PROBE == 6) { GSYNC(); PH5(); } }
    SEAM(5);
    if (IN(6)) { phase6(p); if (PROBE == 5) { GSYNC(); PH5(); GSYNC(); phase6(p); } }
#undef IN
#undef SEAM
}

extern "C" void kernel_launch(void* const* d_in, const int* in_sizes, int n_in, void* d_out, int out_size, void* d_ws, size_t ws_size, hipStream_t stream) {
    static int grid = 0;
    if (grid == 0) {
        if (n_in != 14 || out_size != T * DM || ws_size < WS_END) { fprintf(stderr, "kernel_launch: unexpected sizes n_in %d out %d ws %zu (need %zu)\n", n_in, out_size, ws_size, (size_t)WS_END); grid = -1; return; }
        int dev = 0, cus = 0;
        hipGetDevice(&dev); hipDeviceGetAttribute(&cus, hipDeviceAttributeMultiprocessorCount, dev);
        if (hipFuncSetAttribute((const void*)fwd_kernel, hipFuncAttributeMaxDynamicSharedMemorySize, LDS_BYTES) != hipSuccess) { fprintf(stderr, "kernel_launch: hipFuncSetAttribute failed\n"); grid = -1; return; }
        int per_cu = 0;
        if (hipOccupancyMaxActiveBlocksPerMultiprocessor(&per_cu, (const void*)fwd_kernel, NTHR, LDS_BYTES) != hipSuccess || per_cu < 1) { fprintf(stderr, "kernel_launch: occupancy query says %d\n", per_cu); }
        (void)hipGetLastError();
        grid = cus > 0 ? cus : 256;
    }
    if (grid < 0) return;
    Params p{};
    p.x = (const float*)d_in[0]; p.norm_w = (const float*)d_in[1]; p.w_in = (const float*)d_in[2]; p.b_i = (const float*)d_in[3]; p.b_f = (const float*)d_in[4];
    p.conv_w = (const float*)d_in[5]; p.conv_b = (const float*)d_in[6]; p.dt_bias = (const float*)d_in[7]; p.a_log = (const float*)d_in[8]; p.d_skip = (const float*)d_in[9];
    p.mnw = (const float*)d_in[10]; p.snw = (const float*)d_in[11]; p.w_out = (const float*)d_in[12]; p.fnw = (const float*)d_in[13];
    p.out = (float*)d_out; p.ws = (unsigned char*)d_ws;
    (void)hipMemsetAsync((char*)d_ws + WS_BAR, 0, 16384, stream);
#if ONE_LAUNCH
    p.ph_lo = 0; p.ph_hi = 7;
    void* args[] = {&p};
    hipError_t e = hipLaunchCooperativeKernel((const void*)fwd_kernel, dim3(grid), dim3(NTHR), args, LDS_BYTES, stream);
    if (e != hipSuccess) fprintf(stderr, "cooperative launch failed: %s (grid %d)\n", hipGetErrorString(e), grid);
#else
    for (int ph = 0; ph < 7; ++ph) { p.ph_lo = ph; p.ph_hi = ph + 1; hipLaunchKernelGGL(fwd_kernel, dim3(grid), dim3(NTHR), LDS_BYTES, stream, p); }
#endif
}
```

```cpp
#include <hip/hip_runtime.h>
#include <hip/hip_cooperative_groups.h>
#include <cstdio>
namespace cg = cooperative_groups;

#define LAS __attribute__((address_space(3)))
typedef unsigned short u16;
typedef short bf16x8 __attribute__((ext_vector_type(8)));
typedef float f32x4 __attribute__((ext_vector_type(4)));
typedef float f32x2 __attribute__((ext_vector_type(2)));
typedef unsigned u32x4 __attribute__((ext_vector_type(4)));
typedef unsigned u32x2 __attribute__((ext_vector_type(2)));
typedef __bf16 bf16x2_t __attribute__((ext_vector_type(2)));

#ifndef ONE_LAUNCH
#define ONE_LAUNCH 1
#endif

constexpr int T = 32768, DM = 1024, SEQ = 8192, NCH = 64, CL = 128;
constexpr int DIN = 6680;
constexpr int LDP = 6656;
constexpr int PQ = 0, PK = 512, PV = 1024, PZM = 2048, PO = 3072, PZS = 4096, PX = 5120, PBM = 6144, PCM = 6400;
constexpr int NGT = 32;
constexpr float EPS = 1e-6f, CAP = 15.0f;
constexpr int NTHR = 512;
constexpr int LDS_BYTES = 163840;

constexpr size_t WS_WTIN = 0;
constexpr size_t WS_WTOUT = WS_WTIN + (size_t)LDP * DM * 2;
constexpr size_t WS_G = WS_WTOUT + (size_t)1024 * 2048 * 2;
constexpr size_t WS_NLOC = WS_G + (size_t)T * NGT * 4;
constexpr size_t WS_MBL = WS_NLOC + (size_t)1024 * 128 * 4;
constexpr size_t WS_MGM = WS_MBL + 4096;
constexpr size_t WS_MPREV = WS_MGM + 4096;
constexpr size_t WS_SDEC = WS_MPREV + 4096;
constexpr size_t WS_BAR = WS_SDEC + 16384;
constexpr size_t WS_RSG = WS_BAR + 16384;
constexpr size_t WS_LU = WS_RSG + (size_t)T * 2 * 4;
constexpr size_t WS_LB = WS_LU + (size_t)1024 * 128 * 4;
constexpr size_t WS_SG = WS_LB + (size_t)1024 * 128 * 4;
constexpr size_t WS_H = WS_SG + (size_t)512 * 2048 * 4;
constexpr size_t WS_P = WS_H + (size_t)T * DM * 2;
constexpr size_t WS_END = WS_P + (size_t)T * LDP * 2;

struct Params {
    const float *x, *norm_w, *w_in, *b_i, *b_f, *conv_w, *conv_b, *dt_bias, *a_log, *d_skip, *mnw, *snw, *w_out, *fnw;
    float* out; unsigned char* ws; int ph_lo, ph_hi;
};

__device__ __forceinline__ unsigned pk2(float lo, float hi) { f32x2 v = {lo, hi}; bf16x2_t b = __builtin_convertvector(v, bf16x2_t); return __builtin_bit_cast(unsigned, b); }
__device__ __forceinline__ u16 f2bf(float f) { return (u16)(pk2(f, 0.f) & 0xffffu); }
__device__ __forceinline__ float bf2f(u16 b) { return __uint_as_float((unsigned)b << 16); }
__device__ __forceinline__ float bflo(unsigned u) { return __uint_as_float(u << 16); }
__device__ __forceinline__ float bfhi(unsigned u) { return __uint_as_float(u & 0xffff0000u); }
__device__ __forceinline__ void unpack8(const u32x4 v, float* f) {
    f[0] = bflo(v.x); f[1] = bfhi(v.x); f[2] = bflo(v.y); f[3] = bfhi(v.y); f[4] = bflo(v.z); f[5] = bfhi(v.z); f[6] = bflo(v.w); f[7] = bfhi(v.w);
}
__device__ __forceinline__ float wave_sum(float v) {
#pragma unroll
    for (int o = 1; o < 64; o <<= 1) v += __shfl_xor(v, o);
    return v;
}
__device__ __forceinline__ float siluf(float v) { return v * __builtin_amdgcn_rcpf(1.f + __expf(-v)); }
__device__ __forceinline__ float sigmf(float v) { return __builtin_amdgcn_rcpf(1.f + __expf(-v)); }
__device__ __forceinline__ float softplusf(float v) { return fmaxf(v, 0.f) + log1pf(expf(-fabsf(v))); }
__device__ __forceinline__ float softcap(float v) { return CAP * tanhf(v * (1.0f / CAP)); }
#define LDS_WAIT() asm volatile("s_waitcnt lgkmcnt(0)" ::: "memory")

template <int MT, int NT, int KS>
__device__ __forceinline__ void mma_lds(f32x4 (&acc)[MT][NT], const LAS u16* A, int lda, const LAS u16* B, int ldb, int lane) {
    const int r = lane & 15, q = lane >> 4;
#pragma unroll
    for (int ks = 0; ks < KS; ++ks) {
        asm volatile("" ::: "memory");
        bf16x8 a[MT], b[NT];
#pragma unroll
        for (int m = 0; m < MT; ++m) a[m] = *(const LAS bf16x8*)(A + (m * 16 + r) * lda + ks * 32 + q * 8);
#pragma unroll
        for (int n = 0; n < NT; ++n) b[n] = *(const LAS bf16x8*)(B + (n * 16 + r) * ldb + ks * 32 + q * 8);
#pragma unroll
        for (int m = 0; m < MT; ++m)
#pragma unroll
            for (int n = 0; n < NT; ++n) acc[m][n] = __builtin_amdgcn_mfma_f32_16x16x32_bf16(a[m], b[n], acc[m][n], 0, 0, 0);
    }
}


typedef short v4i16_t __attribute__((ext_vector_type(4)));
__device__ __forceinline__ bf16x8 frag_tr(const LAS u16* X, int ld, int k0, int n0, int lane) {
    const int g = lane >> 4, a = lane & 15;
    const LAS u16* p0 = X + (k0 + 8 * g + (a >> 2)) * ld + n0 + (a & 3) * 4;
    const v4i16_t lo = __builtin_amdgcn_ds_read_tr16_b64_v4i16((LAS v4i16_t*)p0);
    const v4i16_t hi = __builtin_amdgcn_ds_read_tr16_b64_v4i16((LAS v4i16_t*)(p0 + 4 * ld));
    return __builtin_shufflevector(lo, hi, 0, 1, 2, 3, 4, 5, 6, 7);
}
template <int MT, int NT, int KS>
__device__ __forceinline__ void mma_lds_bt(f32x4 (&acc)[MT][NT], const LAS u16* A, int lda, const LAS u16* B, int ldb, int lane) {
    const int r = lane & 15, q = lane >> 4;
#pragma unroll
    for (int ks = 0; ks < KS; ++ks) {
        asm volatile("" ::: "memory");
        bf16x8 a[MT], b[NT];
#pragma unroll
        for (int m = 0; m < MT; ++m) a[m] = *(const LAS bf16x8*)(A + (m * 16 + r) * lda + ks * 32 + q * 8);
#pragma unroll
        for (int n = 0; n < NT; ++n) b[n] = frag_tr(B, ldb, ks * 32, n * 16, lane);
#pragma unroll
        for (int m = 0; m < MT; ++m)
#pragma unroll
            for (int n = 0; n < NT; ++n) acc[m][n] = __builtin_amdgcn_mfma_f32_16x16x32_bf16(a[m], b[n], acc[m][n], 0, 0, 0);
    }
}
template <int MT, int NT, int KS>
__device__ __forceinline__ void mma_lds_tt(f32x4 (&acc)[MT][NT], const LAS u16* A, int lda, const LAS u16* B, int ldb, int lane) {
#pragma unroll
    for (int ks = 0; ks < KS; ++ks) {
        asm volatile("" ::: "memory");
        bf16x8 a[MT], b[NT];
#pragma unroll
        for (int m = 0; m < MT; ++m) a[m] = frag_tr(A, lda, ks * 32, m * 16, lane);
#pragma unroll
        for (int n = 0; n < NT; ++n) b[n] = frag_tr(B, ldb, ks * 32, n * 16, lane);
#pragma unroll
        for (int m = 0; m < MT; ++m)
#pragma unroll
            for (int n = 0; n < NT; ++n) acc[m][n] = __builtin_amdgcn_mfma_f32_16x16x32_bf16(a[m], b[n], acc[m][n], 0, 0, 0);
    }
}

namespace pg8 {
constexpr int BM = 256, BK = 64, HALF = 128, HTB = HALF * BK * 2, STAGE_BYTES = 8 * HTB, NXCD = 8, WGM = 8;
__device__ __forceinline__ int lds_byte(int r, int c) { const int st = (r >> 4) * 2 + (c >> 5), rr = r & 15, cc = c & 31, ob = rr * 64 + cc * 2; return st * 1024 + (ob ^ (((ob >> 9) & 1) << 5)); }
__device__ __forceinline__ void stage_rc(int b, int& R, int& C) { const int st = b / 1024, sb = b % 1024, swz = sb ^ (((sb >> 9) & 1) << 5); R = (st >> 1) * 16 + swz / 64; C = (st & 1) * 32 + (swz % 64) / 2; }
__device__ __forceinline__ int perm32(int rho) { const int n = rho >> 4, i = rho & 15; return 8 * (i >> 2) + 4 * n + (i & 3); }
struct Unit { int pm, pn; };
struct Gemm { const u16* A; const u16* Bt; int M, N, K, lda; };
struct StaticOrder {
    int nM, nN, nwg, G, c;
    __device__ void init(int M, int N, int G_, int c_) { nM = M / BM; nN = N / BM; nwg = nM * nN; G = G_; c = c_; }
    __device__ bool next(int i, Unit& u) const {
        const long Lx = (long)i * G + c; if (Lx >= nwg) return false;
        int wgid = (int)Lx; { const int q = nwg / NXCD, r = nwg % NXCD, xcd = wgid % NXCD, off = wgid / NXCD; wgid = (xcd < r ? xcd * (q + 1) : r * (q + 1) + (xcd - r) * q) + off; }
        const int nig = WGM * nN, gid = wgid / nig, fm = gid * WGM, gsz = (nM - fm) < WGM ? (nM - fm) : WGM;
        u.pm = fm + ((wgid % nig) % gsz); u.pn = (wgid % nig) / gsz; return true;
    }
};
struct EpiP {
    static constexpr bool PERM = true, HORNER = false;
    u16* O; int ldc; const float* rsg;
    __device__ __forceinline__ void operator()(const f32x4 (&acc)[2][2][4][2], const Unit& u, int wr, int wc, int fr, int fq) const {
        const int row0 = u.pm * BM + wr * 64 + fr; const int col0 = u.pn * BM + wc * 32 + 8 * fq;
        if (u.pn >= 8 && u.pn < 16) {
            const int gcol = 2048 + 128 * (u.pn - 8) + wc * 32 + 8 * fq;
#pragma unroll
            for (int ai = 0; ai < 2; ++ai)
#pragma unroll
                for (int m = 0; m < 4; ++m) { u16* rowp = O + (size_t)(row0 + ai * HALF + m * 16) * ldc + gcol;
                    float gt[8];
#pragma unroll
                    for (int n = 0; n < 2; ++n)
#pragma unroll
                        for (int i = 0; i < 4; ++i) { const float zo = acc[ai][1][m][n][i]; gt[n * 4 + i] = zo * __builtin_amdgcn_rcpf((1.f + __expf(-acc[ai][0][m][n][i])) * (1.f + __expf(-zo))); }
                    u32x4 w; w.x = pk2(gt[0], gt[1]); w.y = pk2(gt[2], gt[3]); w.z = pk2(gt[4], gt[5]); w.w = pk2(gt[6], gt[7]);
                    __builtin_nontemporal_store(w, (u32x4*)rowp); }
            return;
        }
        const bool zs_tile = u.pn >= 16 && u.pn < 20;
        const bool lo = fr < 8; const int colb = u.pn * BM + wc * 64 + 8 * fq + (lo ? 0 : 32), rowb = u.pm * BM + wr * 64 + (fr & 7);
#pragma unroll
        for (int ai = 0; ai < 2; ++ai)
#pragma unroll
            for (int m = 0; m < 4; ++m) {
                u32x4 xy[2];
#pragma unroll
                for (int bj = 0; bj < 2; ++bj) { f32x4 v0 = acc[ai][bj][m][0], v1 = acc[ai][bj][m][1];
                    if (zs_tile) {
#pragma unroll
                        for (int i = 0; i < 4; ++i) { v0[i] = siluf(v0[i]); v1[i] = siluf(v1[i]); } }
                    xy[bj].x = pk2(v0[0], v0[1]); xy[bj].y = pk2(v0[2], v0[3]); xy[bj].z = pk2(v1[0], v1[1]); xy[bj].w = pk2(v1[2], v1[3]); }
                const u32x4 snd = lo ? xy[1] : xy[0]; u32x4 rcv;
                rcv.x = (unsigned)__shfl_xor((int)snd.x, 8); rcv.y = (unsigned)__shfl_xor((int)snd.y, 8); rcv.z = (unsigned)__shfl_xor((int)snd.z, 8); rcv.w = (unsigned)__shfl_xor((int)snd.w, 8);
                const u32x4 dA = lo ? xy[0] : rcv, dB = lo ? rcv : xy[1];
                u16* rp = O + (size_t)(rowb + ai * HALF + m * 16) * ldc + colb;
                __builtin_nontemporal_store(dA, (u32x4*)rp);
                __builtin_nontemporal_store(dB, (u32x4*)(rp + (size_t)8 * ldc)); }
    }
};
struct EpiOut {
    static constexpr bool PERM = true, HORNER = true;
    u16* Z; const float* res; int ldc; const float* rsg;
    __device__ __forceinline__ void operator()(const f32x4 (&acc)[2][2][4][2], const Unit& u, int wr, int wc, int fr, int fq, const LAS unsigned char* fac) const {
        const int row0 = u.pm * BM + wr * 64 + fr, col0 = u.pn * BM + wc * 64 + 8 * fq;
#pragma unroll
        for (int ai = 0; ai < 2; ++ai)
#pragma unroll
            for (int m = 0; m < 4; ++m) { u16* rowp = Z + (size_t)(row0 + ai * HALF + m * 16) * ldc + col0;
                const float r1 = ((const LAS float*)fac)[2 * (ai * HALF + wr * 64 + m * 16 + fr) + 1];
#pragma unroll
                for (int bj = 0; bj < 2; ++bj) { const f32x4 v0 = acc[ai][bj][m][0] * r1, v1 = acc[ai][bj][m][1] * r1;
                    u32x4 w; w.x = pk2(v0[0], v0[1]); w.y = pk2(v0[2], v0[3]); w.z = pk2(v1[0], v1[1]); w.w = pk2(v1[2], v1[3]);
                    *(u32x4*)(rowp + bj * 32) = w; } }
    }
};

template <class Epi, class Sched>
__device__ __forceinline__ void gemm_phase(LAS unsigned char* lds, const Gemm g, const Sched& S, const Epi& E) {
    const int tid = threadIdx.x, wid = __builtin_amdgcn_readfirstlane(tid >> 6), lane = tid & 63, wr = wid >> 2, wc = wid & 3, fr = lane & 15, fq = lane >> 4;
    const int K = g.K, nt = K / BK, lda = g.lda;
    unsigned voffA[2], voffB[2];
#pragma unroll
    for (int i = 0; i < 2; ++i) { int R, C; stage_rc(tid * 16 + i * 8192, R, C); const int Rb = Epi::PERM ? ((R >> 5) * 64 + perm32(R & 31)) : R;
        voffA[i] = (unsigned)(R * lda + C) * 2u; voffB[i] = (unsigned)(Rb * K + C) * 2u; }
    const size_t kstep = (size_t)(BK * 2);
    const size_t hstepA = (size_t)HALF * lda * 2, hstepB = (size_t)(Epi::PERM ? 32 : HALF) * K * 2;
    const size_t tstepA = 2 * hstepA, tstepB = (size_t)BM * K * 2;
    const unsigned ldsw = (unsigned)wid * 1024u;
    const int aoff = lds_byte(wr * 64 + fr, fq * 8), boff = lds_byte(wc * 32 + fr, fq * 8);
#define PG8_SA(b, h) (((b) * 2 + (h)) * HTB)
#define PG8_SB(b, h) ((4 + (b) * 2 + (h)) * HTB)
#define PG8_STAGE(bufoff, gbase, voff) do { _Pragma("unroll") for (int _i = 0; _i < 2; ++_i) \
        __builtin_amdgcn_global_load_lds((const unsigned*)((const char*)(gbase) + (voff)[_i]), (LAS unsigned*)(lds + (bufoff) + ldsw + _i * 8192), 16, 0, 0); } while (0)
#define PG8_LDA(dst, b, h) do { _Pragma("unroll") for (int m = 0; m < 4; ++m) _Pragma("unroll") for (int k = 0; k < 2; ++k) dst[m][k] = *(const LAS bf16x8*)(lds + PG8_SA(b, h) + aoff + m * 2048 + k * 1024); } while (0)
#define PG8_LDB(dst, b, h) do { _Pragma("unroll") for (int n = 0; n < 2; ++n) _Pragma("unroll") for (int k = 0; k < 2; ++k) dst[n][k] = *(const LAS bf16x8*)(lds + PG8_SB(b, h) + boff + n * 2048 + k * 1024); } while (0)
#define PG8_MMA(ai, bj, At, Bt) do { __builtin_amdgcn_s_setprio(1); _Pragma("unroll") for (int m = 0; m < 4; ++m) _Pragma("unroll") for (int n = 0; n < 2; ++n) _Pragma("unroll") for (int k = 0; k < 2; ++k) \
        acc[ai][bj][m][n] = __builtin_amdgcn_mfma_f32_16x16x32_bf16(Bt[n][k], At[m][k], acc[ai][bj][m][n], 0, 0, 0); __builtin_amdgcn_s_setprio(0); } while (0)
#define PG8_WAIT_V(n) asm volatile("s_waitcnt vmcnt(" #n ")" ::: "memory")
#define PG8_WAIT_L(n) asm volatile("s_waitcnt lgkmcnt(" #n ")" ::: "memory")
#define PG8_BAR __builtin_amdgcn_s_barrier()
#define PG8_SCHED __builtin_amdgcn_sched_barrier(0)
    Unit cur, nxt; int ui = 0;
    if (!S.next(0, cur)) return;
    f32x4 acc[2][2][4][2];
#pragma unroll
    for (int a = 0; a < 2; ++a)
#pragma unroll
        for (int b = 0; b < 2; ++b)
#pragma unroll
            for (int m = 0; m < 4; ++m)
#pragma unroll
                for (int n = 0; n < 2; ++n) acc[a][b][m][n] = (f32x4){0.f, 0.f, 0.f, 0.f};
    bf16x8 At[4][2], B0[2][2], B1[2][2];
    const char* cA = (const char*)g.A + (size_t)cur.pm * tstepA; const char* cB = (const char*)g.Bt + (size_t)cur.pn * tstepB;
#define PG8_AK(t_) ((size_t)(t_) * kstep)
#define PG8_HLOAD(u_) do { if constexpr (Epi::HORNER) { __builtin_amdgcn_global_load_lds((const unsigned*)(E.rsg + 2 * (size_t)(u_).pm * BM + tid), (LAS unsigned*)(lds + STAGE_BYTES + (ui & 1) * 2048 + wid * 256), 4, 0, 0); } } while (0)
#define PG8_HSCALE(second_) do { _Pragma("unroll") for (int ai = 0; ai < 2; ++ai) _Pragma("unroll") for (int m = 0; m < 4; ++m) { asm volatile("" ::: "memory"); \
        const f32x2 rr_ = *(const LAS f32x2*)(lds + STAGE_BYTES + (ui & 1) * 2048 + 8 * (ai * HALF + wr * 64 + m * 16 + fr)); const float hf_ = (second_) ? rr_.x * __builtin_amdgcn_rcpf(rr_.y) : __builtin_amdgcn_rcpf(rr_.x); \
        _Pragma("unroll") for (int bj = 0; bj < 2; ++bj) _Pragma("unroll") for (int n = 0; n < 2; ++n) acc[ai][bj][m][n] *= hf_; } } while (0)
    PG8_HLOAD(cur);
    PG8_STAGE(PG8_SB(0, 0), cB, voffB); PG8_STAGE(PG8_SA(0, 0), cA + PG8_AK(0), voffA); PG8_STAGE(PG8_SB(0, 1), cB + hstepB, voffB); PG8_STAGE(PG8_SA(0, 1), cA + PG8_AK(0) + hstepA, voffA);
    if (wr == 1) PG8_BAR;
    PG8_WAIT_V(4); PG8_BAR;
    PG8_STAGE(PG8_SB(1, 0), cB + kstep, voffB); PG8_STAGE(PG8_SA(1, 0), cA + PG8_AK(1), voffA); PG8_STAGE(PG8_SB(1, 1), cB + hstepB + kstep, voffB);
    PG8_WAIT_V(6); PG8_BAR;
    for (;;) {
        const bool has_next = S.next(ui + 1, nxt);
        const char* nA = has_next ? (const char*)g.A + (size_t)nxt.pm * tstepA : cA; const char* nB = has_next ? (const char*)g.Bt + (size_t)nxt.pn * tstepB : cB;
#pragma unroll 1
        for (int seg = 0; seg < (Epi::HORNER ? 3 : 1); ++seg) {
        const int tb = Epi::HORNER ? (seg == 0 ? 0 : (seg == 1 ? 16 : 24)) : 0, te = Epi::HORNER ? (seg == 0 ? 16 : (seg == 1 ? 24 : nt)) : nt;
        if constexpr (Epi::HORNER) { if (seg > 0) PG8_HSCALE(seg == 2); }
#pragma unroll 1
        for (int t = tb; t < te; t += 2) {
            const bool last = (t == nt - 2);
            const char* a1 = cA + PG8_AK(t + 1);
            const char* a2 = last ? nA + PG8_AK(0) : cA + PG8_AK(t + 2); const char* b2 = last ? nB : cB + (size_t)(t + 2) * kstep;
            const char* a3 = last ? nA + PG8_AK(1) : cA + PG8_AK(t + 3); const char* b3 = b2 + kstep;
            PG8_LDB(B0, 0, 0); PG8_SCHED; PG8_LDA(At, 0, 0); PG8_STAGE(PG8_SA(1, 1), a1 + hstepA, voffA);
            PG8_WAIT_L(8); PG8_BAR; PG8_WAIT_L(0); PG8_MMA(0, 0, At, B0); PG8_BAR; PG8_SCHED;
            PG8_LDB(B1, 0, 1); PG8_STAGE(PG8_SB(0, 0), b2, voffB);
            PG8_BAR; PG8_WAIT_L(0); PG8_MMA(0, 1, At, B1); PG8_BAR;
            PG8_LDA(At, 0, 1); PG8_STAGE(PG8_SA(0, 0), a2, voffA);
            PG8_BAR; PG8_WAIT_L(0); PG8_MMA(1, 0, At, B0); PG8_BAR; PG8_SCHED;
            PG8_STAGE(PG8_SB(0, 1), b2 + hstepB, voffB);
            PG8_WAIT_V(6); PG8_BAR; PG8_MMA(1, 1, At, B1); PG8_BAR;
            PG8_LDB(B0, 1, 0); PG8_SCHED; PG8_LDA(At, 1, 0); PG8_STAGE(PG8_SA(0, 1), a2 + hstepA, voffA);
            PG8_WAIT_L(8); PG8_BAR; PG8_WAIT_L(0); PG8_MMA(0, 0, At, B0); PG8_BAR; PG8_SCHED;
            PG8_LDB(B1, 1, 1); PG8_STAGE(PG8_SB(1, 0), b3, voffB);
            PG8_BAR; PG8_WAIT_L(0); PG8_MMA(0, 1, At, B1); PG8_BAR;
            PG8_LDA(At, 1, 1); PG8_STAGE(PG8_SA(1, 0), a3, voffA);
            PG8_BAR; PG8_WAIT_L(0); PG8_MMA(1, 0, At, B0); PG8_BAR; PG8_SCHED;
            PG8_STAGE(PG8_SB(1, 1), b3 + hstepB, voffB);
            PG8_WAIT_V(6); PG8_BAR; PG8_MMA(1, 1, At, B1); PG8_BAR;
        }
        }
        if constexpr (Epi::HORNER) E(acc, cur, wr, wc, fr, fq, lds + STAGE_BYTES + (ui & 1) * 2048); else E(acc, cur, wr, wc, fr, fq);
        if (!has_next) break;
#pragma unroll
        for (int a = 0; a < 2; ++a)
#pragma unroll
            for (int b = 0; b < 2; ++b)
#pragma unroll
                for (int m = 0; m < 4; ++m)
#pragma unroll
                    for (int n = 0; n < 2; ++n) acc[a][b][m][n] = (f32x4){0.f, 0.f, 0.f, 0.f};
        cur = nxt; cA = nA; cB = nB; ++ui;
        PG8_HLOAD(cur);
    }
    PG8_WAIT_V(0);
    if (wr == 0) PG8_BAR;
    PG8_BAR;
#undef PG8_AK
#undef PG8_HLOAD
#undef PG8_HSCALE
#undef PG8_SA
#undef PG8_SB
#undef PG8_STAGE
#undef PG8_LDA
#undef PG8_LDB
#undef PG8_MMA
#undef PG8_WAIT_V
#undef PG8_WAIT_L
#undef PG8_BAR
#undef PG8_SCHED
}
}

#include <hip/hip_runtime.h>
#include <cstdio>

#define XB_TMO      128
#define XB_XCNT(j)  (256  + 64 * (j))
#define XB_XSUB(j)  (1280 + 64 * (j))
#define XB_XGEN(j)  (2304 + 64 * (j))
#define XB_TOP      3328
#define XB_TOPGEN   3392
#define XCD_BAR_WORDS 3456
#define XB_SPIN_CAP (1u << 18)

__device__ __forceinline__ unsigned xb_ld(unsigned* p)              { return __hip_atomic_load(p, __ATOMIC_RELAXED, __HIP_MEMORY_SCOPE_AGENT); }
__device__ __forceinline__ unsigned xb_add(unsigned* p, unsigned v) { return __hip_atomic_fetch_add(p, v, __ATOMIC_RELAXED, __HIP_MEMORY_SCOPE_AGENT); }
__device__ __forceinline__ unsigned xb_xcc_id() { return (unsigned)__builtin_amdgcn_s_getreg((3 << 11) | 20) & 0xFu; }
#define XB_SPIN(cond, bar) do { unsigned _sp = 0; while (cond) { __builtin_amdgcn_s_sleep(1); \
    if ((++_sp & 255u) == 0u) { if (xb_ld(&(bar)[XB_TMO])) break; if (_sp > XB_SPIN_CAP) { atomicAdd(&(bar)[XB_TMO], 1u); break; } } } } while (0)

struct XcdBarrier {
    unsigned* bar; unsigned x;
    volatile LAS unsigned* st;
};

__device__ __forceinline__ XcdBarrier xcd_barrier_post(unsigned* bar, volatile LAS unsigned* st) {
    XcdBarrier b; b.bar = bar; b.x = xb_xcc_id(); b.st = st;
    if (threadIdx.x == 0) (void)xb_add(&bar[XB_XCNT(b.x)], 1u);
    return b;
}
__device__ __forceinline__ void xcd_barrier_complete(unsigned* bar, unsigned x, unsigned& nloc, unsigned& nx) {
    const unsigned G = gridDim.x * gridDim.y * gridDim.z;
    unsigned sum, cnt, mine, sp = 0u;
    for (;;) {
        sum = 0u; cnt = 0u; mine = 0u;
#pragma unroll
        for (unsigned j = 0; j < 16; ++j) { const unsigned c = xb_ld(&bar[XB_XCNT(j)]); sum += c; cnt += (c > 0u) ? 1u : 0u; mine = (j == x) ? c : mine; }
        if (sum == G) break;
        __builtin_amdgcn_s_sleep(1);
        if ((++sp & 255u) == 0u) { if (xb_ld(&bar[XB_TMO])) break; if (sp > XB_SPIN_CAP) { atomicAdd(&bar[XB_TMO], 1u); break; } }
    }
    nloc = mine > 0u ? mine : 1u; nx = cnt > 0u ? cnt : 1u;
}

__device__ __forceinline__ void xcd_barrier(const XcdBarrier& b) {
    asm volatile("s_waitcnt vmcnt(0)" ::: "memory");
    __syncthreads();
    if (threadIdx.x == 0) {
        unsigned* bar = b.bar;
        __builtin_amdgcn_s_waitcnt(0);
        unsigned nloc = b.st[0], nx = b.st[1];
        if (nloc == 0u) { xcd_barrier_complete(bar, b.x, nloc, nx); b.st[0] = nloc; b.st[1] = nx; }
        const unsigned old = xb_add(&bar[XB_XSUB(b.x)], 1u);
        const unsigned gen = old / nloc;
        if (old + 1u == (gen + 1u) * nloc) {
            __builtin_amdgcn_fence(__ATOMIC_RELEASE, "agent");
            asm volatile("s_waitcnt vmcnt(0)" ::: "memory");
            const unsigned og = xb_add(&bar[XB_TOP], 1u);
            const unsigned tg = og / nx;
            if (og + 1u == (tg + 1u) * nx) xb_add(&bar[XB_TOPGEN], 1u);
            else XB_SPIN(xb_ld(&bar[XB_TOPGEN]) == tg, bar);
            __builtin_amdgcn_fence(__ATOMIC_ACQUIRE, "agent");
            xb_add(&bar[XB_XGEN(b.x)], 1u);
            asm volatile("s_waitcnt vmcnt(0)" ::: "memory");
        } else {
            XB_SPIN(xb_ld(&bar[XB_XGEN(b.x)]) == gen, bar);
            __builtin_amdgcn_fence(__ATOMIC_ACQUIRE, "agent");
            asm volatile("s_waitcnt vmcnt(0)" ::: "memory");
        }
    }
    __syncthreads();
}

__device__ __forceinline__ int src_col(int n) {
    if (n < 2048) return n;
    if (n < 4096) { const int cb = (n - 2048) >> 8, off = (n - 2048) & 255;
        const int w = off >> 6, hsel = (off >> 5) & 1; return (hsel ? 3080 : 2056) + 128 * cb + 32 * w; }
    if (n < 5120) return 4104 + (n - 4096);
    return 5128 + (n - 5120);
}
__device__ __forceinline__ void transpose_item(const float* W, int ldw, int K, int srccol, u16* WT, int dstrow, LAS float* scr, int k0, int lane, int k0src, const float* rs) {
#pragma unroll 8
    for (int i = 0; i < 32; ++i) { const int kk = 2 * i + (lane >> 5); float v = W[(size_t)(k0src + kk) * ldw + srccol + (lane & 31)]; if (rs) v *= rs[k0 + kk]; scr[kk * 33 + (lane & 31)] = v; }
    LDS_WAIT();
    const int c = lane & 7;
#pragma unroll
    for (int j = 0; j < 4; ++j) { const int n = (lane >> 3) + 8 * j; const LAS float* s = scr + (8 * c) * 33 + n;
        u32x4 o; o.x = pk2(s[0 * 33], s[1 * 33]); o.y = pk2(s[2 * 33], s[3 * 33]); o.z = pk2(s[4 * 33], s[5 * 33]); o.w = pk2(s[6 * 33], s[7 * 33]);
        *(u32x4*)(WT + (size_t)(dstrow + n) * K + k0 + 8 * c) = o; }
    LDS_WAIT();
}

__device__ __forceinline__ void phase0(const Params& p, LAS unsigned char* lds) {
    const int tid = threadIdx.x, lane = tid & 63, wave = tid >> 6;
    const int gw = blockIdx.x * 8 + wave, NGW = gridDim.x * 8;
    u16* WtIn = (u16*)(p.ws + WS_WTIN); u16* WtOut = (u16*)(p.ws + WS_WTOUT);
    {
        LAS float* scr = (LAS float*)(lds + wave * 16384);
        constexpr int I_IN = 16 * 208, I_OUT = 32 * 32;
        for (int it = gw; it < I_IN + I_OUT; it += NGW) {
            if (it < I_IN) { const int kb = it / 208, nb = it % 208; transpose_item(p.w_in, DIN, 1024, src_col(32 * nb), WtIn, 32 * nb, scr, 64 * kb, lane, 64 * kb, nullptr); }
            else { const int r = it - I_IN; const int kb = r / 32, nb = r % 32; transpose_item(p.w_out, 1024, 2048, 32 * nb, WtOut, 32 * nb, scr, 64 * kb, lane, 64 * kb, kb >= 16 ? p.snw - 1024 : nullptr); }
        }
    }
    __syncthreads();
    LAS float* wg = (LAS float*)lds;
    for (int idx = tid; idx < 1024 * 24; idx += NTHR) {
        const int k = idx / 24, gc = idx % 24; const int col = gc < 8 ? 2048 + gc : 6664 + (gc - 8);
        const float v = p.w_in[(size_t)k * DIN + col];
        const int ln = (k & 255) >> 2, e = k & 3, j = k >> 8, c4 = gc >> 2, cm = gc & 3;
        wg[((((j * 4 + e) * 6 + c4) * 64 + ln) << 2) + cm] = v;
    }
    __syncthreads();
    u16* H = (u16*)(p.ws + WS_H); float* G = (float*)(p.ws + WS_G);
    f32x4 nw[4];
#pragma unroll
    for (int j = 0; j < 4; ++j) nw[j] = ((const f32x4*)p.norm_w)[lane + 64 * j];
    f32x4 vn[2][4];
#pragma unroll
    for (int r = 0; r < 2; ++r)
#pragma unroll
        for (int j = 0; j < 4; ++j) vn[r][j] = __builtin_nontemporal_load((const f32x4*)(p.x + (size_t)(2 * gw + r) * DM) + lane + 64 * j);
    for (int pr = gw; pr < T / 2; pr += NGW) {
        f32x4 v[2][4];
#pragma unroll
        for (int r = 0; r < 2; ++r)
#pragma unroll
            for (int j = 0; j < 4; ++j) v[r][j] = vn[r][j];
        { const int prn = (pr + NGW < T / 2) ? pr + NGW : pr;
#pragma unroll
          for (int r = 0; r < 2; ++r)
#pragma unroll
            for (int j = 0; j < 4; ++j) vn[r][j] = __builtin_nontemporal_load((const f32x4*)(p.x + (size_t)(2 * prn + r) * DM) + lane + 64 * j); }
#pragma unroll
        for (int r = 0; r < 2; ++r) {
            float s = 0.f;
#pragma unroll
            for (int j = 0; j < 4; ++j) s += (v[r][j].x * v[r][j].x + v[r][j].y * v[r][j].y) + (v[r][j].z * v[r][j].z + v[r][j].w * v[r][j].w);
            const float rstd = rsqrtf(wave_sum(s) * (1.f / DM) + EPS);
            u32x2* o8 = (u32x2*)(H + (size_t)(2 * pr + r) * DM) + lane;
#pragma unroll
            for (int j = 0; j < 4; ++j) { v[r][j] = v[r][j] * rstd * nw[j]; u32x2 o; o.x = pk2(v[r][j].x, v[r][j].y); o.y = pk2(v[r][j].z, v[r][j].w); o8[64 * j] = o; }
        }
        f32x2 a2[2][12];
#pragma unroll
        for (int i = 0; i < 12; ++i) { a2[0][i] = (f32x2){0.f, 0.f}; a2[1][i] = (f32x2){0.f, 0.f}; }
#pragma unroll
        for (int j = 0; j < 4; ++j)
#pragma unroll
            for (int e = 0; e < 4; ++e) {
                asm volatile("" ::: "memory");
#pragma unroll
                for (int c4 = 0; c4 < 6; ++c4) {
                    const f32x4 w = *(const LAS f32x4*)(wg + ((((j * 4 + e) * 6 + c4) * 64 + lane) << 2));
                    const f32x2 wlo = {w.x, w.y}, whi = {w.z, w.w};
                    const f32x2 h0 = {v[0][j][e], v[0][j][e]}, h1 = {v[1][j][e], v[1][j][e]};
                    a2[0][c4 * 2] = __builtin_elementwise_fma(h0, wlo, a2[0][c4 * 2]); a2[0][c4 * 2 + 1] = __builtin_elementwise_fma(h0, whi, a2[0][c4 * 2 + 1]);
                    a2[1][c4 * 2] = __builtin_elementwise_fma(h1, wlo, a2[1][c4 * 2]); a2[1][c4 * 2 + 1] = __builtin_elementwise_fma(h1, whi, a2[1][c4 * 2 + 1]);
                } }
        float a[48];
#pragma unroll
        for (int i = 0; i < 24; ++i) { a[i] = a2[0][i >> 1][i & 1]; a[24 + i] = a2[1][i >> 1][i & 1]; }
        float b24[24], b12[12], b6[6], b3[3];
        { const bool hi = (lane & 32) != 0;
#pragma unroll
          for (int i = 0; i < 24; ++i) { const float snd = hi ? a[i] : a[i + 24], kp = hi ? a[i + 24] : a[i]; b24[i] = kp + __shfl_xor(snd, 32); } }
        { const bool hi = (lane & 16) != 0;
#pragma unroll
          for (int i = 0; i < 12; ++i) { const float snd = hi ? b24[i] : b24[i + 12], kp = hi ? b24[i + 12] : b24[i]; b12[i] = kp + __shfl_xor(snd, 16); } }
        { const bool hi = (lane & 8) != 0;
#pragma unroll
          for (int i = 0; i < 6; ++i) { const float snd = hi ? b12[i] : b12[i + 6], kp = hi ? b12[i + 6] : b12[i]; b6[i] = kp + __shfl_xor(snd, 8); } }
        { const bool hi = (lane & 4) != 0;
#pragma unroll
          for (int i = 0; i < 3; ++i) { const float snd = hi ? b6[i] : b6[i + 3], kp = hi ? b6[i + 3] : b6[i]; b3[i] = kp + __shfl_xor(snd, 4); } }
#pragma unroll
        for (int i = 0; i < 3; ++i) { b3[i] += __shfl_xor(b3[i], 2); b3[i] += __shfl_xor(b3[i], 1); }
        if ((lane & 3) == 0) {
            const int base = ((lane >> 5) & 1) * 24 + ((lane >> 4) & 1) * 12 + ((lane >> 3) & 1) * 6 + ((lane >> 2) & 1) * 3;
#pragma unroll
            for (int i = 0; i < 3; ++i) { const int idx = base + i; const int r = idx / 24, gc = idx % 24; G[(size_t)(2 * pr + r) * NGT + gc] = b3[i]; }
        }
    }
}

__device__ __forceinline__ float scan128_sum(float v, LAS float* s_tot) {
    const int lane = threadIdx.x & 63;
#pragma unroll
    for (int o = 1; o < 64; o <<= 1) { const float t = __shfl_up(v, o); if (lane >= o) v += t; }
    if (threadIdx.x == 63) *s_tot = v;
    __syncthreads();
    if (threadIdx.x >= 64 && threadIdx.x < 128) v += *s_tot;
    return v;
}
__device__ __forceinline__ float scan128_max(float v, LAS float* s_tot) {
    const int lane = threadIdx.x & 63;
#pragma unroll
    for (int o = 1; o < 64; o <<= 1) { const float t = __shfl_up(v, o); if (lane >= o) v = fmaxf(v, t); }
    if (threadIdx.x == 63) *s_tot = v;
    __syncthreads();
    if (threadIdx.x >= 64 && threadIdx.x < 128) v = fmaxf(v, *s_tot);
    return v;
}
__device__ __forceinline__ void mlstm_gates(float ipr, float fpr, LAS float* s_li, LAS float* s_lf, LAS float* s_b) {
    const int tid = threadIdx.x;
    float lf = 0.f;
    if (tid < CL) {
        const float fc = softcap(fpr);
        s_li[tid] = softcap(ipr);
        lf = fminf(fc, 0.f) - log1pf(expf(-fabsf(fc)));
    }
    const float b = scan128_sum(lf, s_lf);
    if (tid < CL) s_b[tid] = b;
    __syncthreads();
}
__device__ __forceinline__ void ssd_gates(const Params& p, int t0, int g, LAS float* s_dt, LAS float* s_ac, LAS float* s_tmp) {
    const int tid = threadIdx.x, lane = tid & 63, hh = tid >> 6, head = g * 8 + hh; const float* G = (const float*)(p.ws + WS_G);
    const float g0 = G[(size_t)(t0 + lane) * NGT + 8 + head], g1 = G[(size_t)(t0 + lane + 64) * NGT + 8 + head];
    const float db = p.dt_bias[head], A = -expf(p.a_log[head]);
    float carry = 0.f;
#pragma unroll
    for (int hf = 0; hf < 2; ++hf) { const int s = lane + 64 * hf;
        const float dtv = softplusf((hf ? g1 : g0) + db);
        float v = dtv * A;
#pragma unroll
        for (int o = 1; o < 64; o <<= 1) { const float t = __shfl_up(v, o); if (lane >= o) v += t; }
        v += carry; carry = __shfl(v, 63);
        s_dt[hh * 128 + s] = dtv; s_ac[hh * 128 + s] = v; }
    __syncthreads();
}
struct ConvW { f32x4 w[8]; float b[8]; };
__device__ __forceinline__ void conv_load(const Params& p, int ch, ConvW& cw) {
#pragma unroll
    for (int i = 0; i < 8; ++i) { cw.w[i] = ((const f32x4*)p.conv_w)[ch + i]; cw.b[i] = p.conv_b[ch + i]; }
}
__device__ __forceinline__ void conv8(const u16* P, const ConvW& cw, int t, int tl, int ch, float* out) {
    u32x4 v[4];
#pragma unroll
    for (int w = 0; w < 4; ++w) { const int d = 3 - w, dd = (tl >= d) ? d : 0; v[w] = *(const u32x4*)(P + (size_t)(t - dd) * LDP + PX + ch); }
    float acc[8];
#pragma unroll
    for (int i = 0; i < 8; ++i) acc[i] = cw.b[i];
#pragma unroll
    for (int w = 0; w < 4; ++w) { const float m = (tl >= 3 - w) ? 1.f : 0.f; float f[8]; unpack8(v[w], f);
#pragma unroll
        for (int i = 0; i < 8; ++i) acc[i] += f[i] * (cw.w[i][w] * m); }
#pragma unroll
    for (int i = 0; i < 8; ++i) out[i] = siluf(acc[i]);
}


__device__ __forceinline__ void conv_roll_load(const u16* P, int t0, int tl0, int s0, int ch, u32x4* raw) {
#pragma unroll
    for (int k = 0; k < 11; ++k) { const int tl = tl0 + s0 - 3 + k; const int rr = tl >= 0 ? t0 + s0 - 3 + k : t0; raw[k] = *(const u32x4*)(P + (size_t)rr * LDP + PX + ch); }
}
__device__ __forceinline__ void conv_roll_row(const u32x4* raw, const ConvW& cw, int j, float m0, float* acc) {
#pragma unroll
    for (int e = 0; e < 8; ++e) acc[e] = cw.b[e];
#pragma unroll
    for (int w = 0; w < 4; ++w) { const float mm = (j + w < 3) ? m0 : 1.f; float f[8]; unpack8(raw[j + w], f);
#pragma unroll
        for (int e = 0; e < 8; ++e) acc[e] += f[e] * (cw.w[e][w] * mm); }
#pragma unroll
    for (int e = 0; e < 8; ++e) acc[e] = siluf(acc[e]);
}

constexpr int LP = 136;
struct M2Pre { float ipr, fpr; u32x4 kv[4], vv[8]; };
__device__ __forceinline__ void m2_load(const Params& p, int item, M2Pre& r) {
    const int tid = threadIdx.x, h = item & 3, t0 = (item >> 2) * CL, ss = tid >> 2, part = tid & 3;
    const u16* P = (const u16*)(p.ws + WS_P); const float* G = (const float*)(p.ws + WS_G);
    r.ipr = 0.f; r.fpr = 0.f;
    if (tid < CL) { r.ipr = G[(size_t)(t0 + tid) * NGT + h]; r.fpr = G[(size_t)(t0 + tid) * NGT + 4 + h]; }
    const u16* kr = P + (size_t)(t0 + ss) * LDP + PK + h * 128 + part * 32;
    const u16* vr = P + (size_t)(t0 + ss) * LDP + PV + h * 256 + part * 64;
#pragma unroll
    for (int c = 0; c < 4; ++c) r.kv[c] = *(const u32x4*)(kr + c * 8);
#pragma unroll
    for (int c = 0; c < 8; ++c) r.vv[c] = *(const u32x4*)(vr + c * 8);
}
__device__ __forceinline__ void phase2_mlstm(const Params& p, LAS unsigned char* lds, int item, M2Pre& pre, int next_item) {
    const int tid = threadIdx.x, lane = tid & 63, wave = tid >> 6;
    const int h = item & 3, bc = item >> 2, t0 = bc * CL;
    LAS u16* KT = (LAS u16*)lds;
    LAS u16* VT = (LAS u16*)(lds + 34816);
    LAS float* sm = (LAS float*)(lds + 34816 + 67584);
    LAS float *s_li = sm, *s_lf = sm + 128, *s_b = sm + 256, *s_w = sm + 384;
    const float bi_h = p.b_i[h], bf_h = p.b_f[h];
    const int ss = tid >> 2, part = tid & 3;
    const float ipr = pre.ipr, fpr = pre.fpr;
    float li = 0.f, lf = 0.f;
    if (tid < CL) { const float fc = softcap(fpr + bf_h); li = softcap(ipr + bi_h); lf = fminf(fc, 0.f) - log1pf(expf(-fabsf(fc))); }
    const float bcum = scan128_sum(lf, s_lf);
    float uv = -3.0e38f;
    if (tid < CL) { uv = li - bcum; ((float*)(p.ws + WS_LU))[(size_t)item * 128 + tid] = uv; ((float*)(p.ws + WS_LB))[(size_t)item * 128 + tid] = bcum; }
    float um = uv;
#pragma unroll
    for (int o = 1; o < 64; o <<= 1) um = fmaxf(um, __shfl_xor(um, o));
    if (lane == 0 && wave < 2) s_li[wave] = um;
    if (tid < CL) s_w[tid] = uv;
    __syncthreads();
    const float umax = fmaxf(s_li[0], s_li[1]);
    if (tid == CL - 1) { ((float*)(p.ws + WS_MBL))[item] = bcum; ((float*)(p.ws + WS_MGM))[item] = bcum + umax; }
    (void)s_b;
    {
        const float w = expf(s_w[ss] - umax);
#pragma unroll
        for (int c = 0; c < 4; ++c) { float f[8]; unpack8(pre.kv[c], f);
            u32x4 o; o.x = pk2(f[0] * w, f[1] * w); o.y = pk2(f[2] * w, f[3] * w); o.z = pk2(f[4] * w, f[5] * w); o.w = pk2(f[6] * w, f[7] * w);
            *(LAS u32x4*)(KT + ss * LP + part * 32 + c * 8) = o; }
#pragma unroll
        for (int c = 0; c < 8; ++c) *(LAS u32x4*)(VT + ss * 264 + part * 64 + c * 8) = pre.vv[c];
    }
    m2_load(p, next_item, pre);
    __syncthreads();
    {
        f32x4 nacc = {0.f, 0.f, 0.f, 0.f};
        const bf16x8 ones = {(short)0x3F80, (short)0x3F80, (short)0x3F80, (short)0x3F80, (short)0x3F80, (short)0x3F80, (short)0x3F80, (short)0x3F80};
#pragma unroll
        for (int ks = 0; ks < 4; ++ks) nacc = __builtin_amdgcn_mfma_f32_16x16x32_bf16(ones, frag_tr(KT, LP, ks * 32, wave * 16, lane), nacc, 0, 0, 0);
        if ((lane >> 4) == 0) ((float*)(p.ws + WS_NLOC))[(size_t)item * 128 + wave * 16 + (lane & 15)] = nacc[0];
    }
    f32x4 acc[8][2];
#pragma unroll
    for (int m = 0; m < 8; ++m)
#pragma unroll
        for (int n = 0; n < 2; ++n) acc[m][n] = (f32x4){0.f, 0.f, 0.f, 0.f};
    mma_lds_tt<8, 2, 4>(acc, KT, LP, VT + wave * 32, 264, lane);
    u16* CS = (u16*)p.out + (size_t)item * 32768;
    const int r = lane & 15, q = lane >> 4;
    {
        u16* dst = CS + (wave * 32 + (q & 1) * 16 + r) * 128 + (q >> 1) * 8;
#pragma unroll
        for (int m = 0; m < 8; ++m) {
            unsigned x0 = pk2(acc[m][0][0], acc[m][0][1]), x1 = pk2(acc[m][0][2], acc[m][0][3]);
            unsigned y0 = pk2(acc[m][1][0], acc[m][1][1]), y1 = pk2(acc[m][1][2], acc[m][1][3]);
            auto s0 = __builtin_amdgcn_permlane16_swap(x0, y0, false, false); x0 = s0[0]; y0 = s0[1];
            auto s1 = __builtin_amdgcn_permlane16_swap(x1, y1, false, false); x1 = s1[0]; y1 = s1[1];
            const u32x4 o = {x0, x1, y0, y1};
            *(u32x4*)(dst + m * 16) = o;
        }
    }
    __syncthreads();
}

__device__ __forceinline__ void phase2_ssd(const Params& p, LAS unsigned char* lds, int item) {
    const int tid = threadIdx.x, lane = tid & 63, wave = tid >> 6;
    const int g = item & 1, bc = item >> 1, t0 = bc * CL, tl0 = (bc & (NCH - 1)) * CL;
    const u16* P = (const u16*)(p.ws + WS_P); u16* XC = (u16*)(p.ws + WS_H);
    LAS u16* BN = (LAS u16*)lds;
    LAS u16* XD = (LAS u16*)(lds + 34816);
    LAS float* sm = (LAS float*)(lds + 34816 + 67584);
    LAS float *s_dt = sm, *s_ac = sm + 1024;
    const int cg = tid & 31, s0 = (tid >> 5) * 8;
    u32x4 raw[11];
#define SSD2_LOAD(half) do { _Pragma("unroll") for (int k = 0; k < 11; ++k) { const int tl = tl0 + s0 - 3 + k; const int rr = tl >= 0 ? t0 + s0 - 3 + k : t0; \
        raw[k] = *(const u32x4*)(P + (size_t)rr * LDP + PX + g * 512 + (half) * 256 + cg * 8); } } while (0)
    SSD2_LOAD(0);
    ssd_gates(p, t0, g, s_dt, s_ac, sm + 2048);
    { float* sg = (float*)(p.ws + WS_SG) + (size_t)item * 2048; sg[tid] = s_dt[tid]; sg[tid + 512] = s_dt[tid + 512]; sg[1024 + tid] = s_ac[tid]; sg[1536 + tid] = s_ac[tid + 512]; }
    if (tid < 8) ((float*)(p.ws + WS_SDEC))[item * 8 + tid] = expf(s_ac[tid * 128 + 127]);
    if (tid < 256) {
        const int cgp = tid & 15, sb = (tid >> 4) * 8, chb = 1024 + g * 128 + cgp * 8;
        u32x4 rawb[11]; conv_roll_load(P, t0, tl0, sb, chb, rawb);
        ConvW cw; conv_load(p, chb, cw);
        const float m0 = (tl0 + sb - 3 >= 0) ? 1.f : 0.f;
#pragma unroll
        for (int j = 0; j < 8; ++j) { float f[8]; conv_roll_row(rawb, cw, j, m0, f);
            u32x4 o; o.x = pk2(f[0], f[1]); o.y = pk2(f[2], f[3]); o.z = pk2(f[4], f[5]); o.w = pk2(f[6], f[7]); *(LAS u32x4*)(BN + (sb + j) * LP + cgp * 8) = o; }
    }
    u16* HS = (u16*)p.out + (size_t)1024 * 32768;
    const int r = lane & 15, q = lane >> 4;
#pragma unroll 1
    for (int hb = 0; hb < 2; ++hb) {
        {
            const int ch = g * 512 + hb * 256 + cg * 8, hh = hb * 4 + (cg >> 3);
            ConvW cw; conv_load(p, ch, cw);
            const float alast = s_ac[hh * 128 + 127];
            float m0 = (tl0 + s0 - 3 >= 0) ? 1.f : 0.f;
#pragma unroll
            for (int j = 0; j < 8; ++j) {
                float acc[8];
#pragma unroll
                for (int e = 0; e < 8; ++e) acc[e] = cw.b[e];
#pragma unroll
                for (int w = 0; w < 4; ++w) { const float mm = (j + w < 3) ? m0 : 1.f; float f[8]; unpack8(raw[j + w], f);
#pragma unroll
                    for (int e = 0; e < 8; ++e) acc[e] += f[e] * (cw.w[e][w] * mm); }
#pragma unroll
                for (int e = 0; e < 8; ++e) acc[e] = siluf(acc[e]);
                const int sr = s0 + j; const float sc = s_dt[hh * 128 + sr] * expf(alast - s_ac[hh * 128 + sr]);
                u32x4 o; o.x = pk2(acc[0], acc[1]); o.y = pk2(acc[2], acc[3]); o.z = pk2(acc[4], acc[5]); o.w = pk2(acc[6], acc[7]);
                *(u32x4*)(XC + (size_t)(t0 + sr) * 1024 + ch) = o;
                o.x = pk2(acc[0] * sc, acc[1] * sc); o.y = pk2(acc[2] * sc, acc[3] * sc); o.z = pk2(acc[4] * sc, acc[5] * sc); o.w = pk2(acc[6] * sc, acc[7] * sc);
                *(LAS u32x4*)(XD + sr * 264 + cg * 8) = o;
            }
        }
        if (hb == 0) SSD2_LOAD(1);
        __syncthreads();
        const int h4 = wave >> 1, nh = wave & 1, head = g * 8 + hb * 4 + h4;
        f32x4 acc[4][4];
#pragma unroll
        for (int m = 0; m < 4; ++m)
#pragma unroll
            for (int n = 0; n < 4; ++n) acc[m][n] = (f32x4){0.f, 0.f, 0.f, 0.f};
        mma_lds_tt<4, 4, 4>(acc, BN + nh * 64, LP, XD + h4 * 64, 264, lane);
        u16* dst = HS + ((size_t)bc * 16 + head) * 8192;
#pragma unroll
        for (int m = 0; m < 4; ++m)
#pragma unroll
            for (int n2 = 0; n2 < 4; n2 += 2) {
                unsigned x0 = pk2(acc[m][n2][0], acc[m][n2][1]), x1 = pk2(acc[m][n2][2], acc[m][n2][3]);
                unsigned y0 = pk2(acc[m][n2 + 1][0], acc[m][n2 + 1][1]), y1 = pk2(acc[m][n2 + 1][2], acc[m][n2 + 1][3]);
                auto s0 = __builtin_amdgcn_permlane16_swap(x0, y0, false, false); x0 = s0[0]; y0 = s0[1];
                auto s1 = __builtin_amdgcn_permlane16_swap(x1, y1, false, false); x1 = s1[0]; y1 = s1[1];
                const u32x4 o = {x0, x1, y0, y1};
                *(u32x4*)(dst + ((n2 + (q & 1)) * 16 + r) * 128 + nh * 64 + m * 16 + (q >> 1) * 8) = o; }
        __syncthreads();
    }
#undef SSD2_LOAD
}

__device__ __forceinline__ void phase3(const Params& p) {
    const int gtid = blockIdx.x * NTHR + threadIdx.x, nthr = gridDim.x * NTHR;
    for (int w = gtid; w < 131072; w += nthr) {
        if (w < 65536) {
            const int bh = w >> 12, e8 = w & 4095, b = bh >> 2, h = bh & 3;
            u16* CS = (u16*)p.out; const float* MBL = (const float*)(p.ws + WS_MBL); const float* MGM = (const float*)(p.ws + WS_MGM);
            float* MPREV = (float*)(p.ws + WS_MPREV); float* NL = (float*)(p.ws + WS_NLOC);
            float C[8]; float m = 0.f;
#pragma unroll
            for (int i = 0; i < 8; ++i) C[i] = 0.f;
            u32x4 vn[8]; float an[8], gn[8], nn[8]; float nv = 0.f; const int en = e8 & 127;
#define P3_LOAD(c0_) do { _Pragma("unroll") for (int j = 0; j < 8; ++j) { const int it_ = (b * NCH + (c0_) + j) * 4 + h; vn[j] = *(const u32x4*)(CS + (size_t)it_ * 32768 + e8 * 8); an[j] = MBL[it_]; gn[j] = MGM[it_]; nn[j] = NL[(size_t)it_ * 128 + en]; } } while (0)
            P3_LOAD(0);
#pragma unroll 1
            for (int c0 = 0; c0 < NCH; c0 += 8) {
                u32x4 v[8]; float av[8], gv[8], nl[8];
#pragma unroll
                for (int j = 0; j < 8; ++j) { v[j] = vn[j]; av[j] = an[j]; gv[j] = gn[j]; nl[j] = nn[j]; }
                if (c0 + 8 < NCH) P3_LOAD(c0 + 8);
#pragma unroll
                for (int j = 0; j < 8; ++j) {
                    const int item = (b * NCH + c0 + j) * 4 + h;
                    const float a = av[j], gm = gv[j];
                    const float mn = fmaxf(a + m, gm), so = __expf(a + m - mn), sl = __expf(gm - mn);
                    float f[8]; unpack8(v[j], f);
                    u32x4 o; o.x = pk2(C[0], C[1]); o.y = pk2(C[2], C[3]); o.z = pk2(C[4], C[5]); o.w = pk2(C[6], C[7]);
                    *(u32x4*)(CS + (size_t)item * 32768 + e8 * 8) = o;
#pragma unroll
                    for (int i = 0; i < 8; ++i) C[i] = so * C[i] + sl * f[i];
                    if (e8 < 128) { NL[(size_t)item * 128 + e8] = nv; if (e8 == 0) MPREV[item] = m; }
                    nv = so * nv + sl * nl[j];
                    m = mn;
                }
            }
#undef P3_LOAD
        } else {
            const int idx = w - 65536, bhd = idx >> 10, e8 = idx & 1023, b = bhd >> 4, head = bhd & 15;
            u16* HS = (u16*)p.out + (size_t)1024 * 32768; const float* SD = (const float*)(p.ws + WS_SDEC);
            float hs[8];
#pragma unroll
            for (int i = 0; i < 8; ++i) hs[i] = 0.f;
            u32x4 vn[8]; float dn[8];
#define P3_LOAD(c0_) do { _Pragma("unroll") for (int j = 0; j < 8; ++j) { const int bc_ = b * NCH + (c0_) + j; vn[j] = *(const u32x4*)(HS + ((size_t)bc_ * 16 + head) * 8192 + e8 * 8); dn[j] = SD[(bc_ * 2 + (head >> 3)) * 8 + (head & 7)]; } } while (0)
            P3_LOAD(0);
#pragma unroll 1
            for (int c0 = 0; c0 < NCH; c0 += 8) {
                u32x4 v[8]; float dv[8];
#pragma unroll
                for (int j = 0; j < 8; ++j) { v[j] = vn[j]; dv[j] = dn[j]; }
                if (c0 + 8 < NCH) P3_LOAD(c0 + 8);
#pragma unroll
                for (int j = 0; j < 8; ++j) {
                    const int bc = b * NCH + c0 + j;
                    float f[8]; unpack8(v[j], f);
                    u32x4 o; o.x = pk2(hs[0], hs[1]); o.y = pk2(hs[2], hs[3]); o.z = pk2(hs[4], hs[5]); o.w = pk2(hs[6], hs[7]);
                    *(u32x4*)(HS + ((size_t)bc * 16 + head) * 8192 + e8 * 8) = o;
#pragma unroll
                    for (int i = 0; i < 8; ++i) hs[i] = dv[j] * hs[i] + f[i];
                }
            }
#undef P3_LOAD
        }
    }
}

struct M4Pre { float ipr, fpr, npv, mprev; u32x4 qv[4], kv[4]; };
__device__ __forceinline__ void m4_load(const Params& p, int item, M4Pre& r) {
    const int tid = threadIdx.x, h = item & 3, t0 = (item >> 2) * CL, ss = tid >> 2, part = tid & 3;
    const u16* prow = (const u16*)(p.ws + WS_P) + (size_t)(t0 + ss) * LDP; const float* G = (const float*)(p.ws + WS_G);
    r.ipr = 0.f; r.fpr = 0.f; r.npv = 0.f;
    if (tid < CL) { r.ipr = ((const float*)(p.ws + WS_LU))[(size_t)item * 128 + tid]; r.fpr = ((const float*)(p.ws + WS_LB))[(size_t)item * 128 + tid]; r.npv = ((const float*)(p.ws + WS_NLOC))[(size_t)item * 128 + tid]; }
    (void)G;
    r.mprev = ((const float*)(p.ws + WS_MPREV))[item];
#pragma unroll
    for (int c = 0; c < 4; ++c) { r.qv[c] = *(const u32x4*)(prow + PQ + h * 128 + part * 32 + c * 8); r.kv[c] = *(const u32x4*)(prow + PK + h * 128 + part * 32 + c * 8); }
}
__device__ __forceinline__ void phase4_mlstm(const Params& p, LAS unsigned char* lds, int item, M4Pre& pre, int next_item, bool first) {
    const int tid = threadIdx.x, lane = tid & 63, wave = tid >> 6;
    const int h = item & 3, bc = item >> 2, t0 = bc * CL;
    u16* P = (u16*)(p.ws + WS_P); const float* G = (const float*)(p.ws + WS_G);
    LAS u16* Q = (LAS u16*)lds;
    LAS u16* KS = (LAS u16*)(lds + 34816);
    LAS u16* VT = (LAS u16*)(lds + 69632);
    LAS u16* CP = (LAS u16*)(lds + 104448);
    LAS float* HB = (LAS float*)lds;
    LAS float* sm = (LAS float*)(lds + 139264);
    LAS float *s_li = sm, *s_lf = sm + 128, *s_b = sm + 256, *s_u = sm + 384, *s_M = sm + 512, *s_np = sm + 768;
    const int ss = tid >> 2, part = tid & 3;
    const u16* CS = (const u16*)p.out + (size_t)item * 32768;
    const u16* prow = P + (size_t)(t0 + ss) * LDP;
    const float ipr = pre.ipr, fpr = pre.fpr, npv = pre.npv, mprev = pre.mprev;
    if (first) { if (tid < 256) sm[896 + tid] = p.mnw[h * 256 + tid]; }
    float uv = -3.0e38f;
    if (tid < CL) { uv = ipr; s_u[tid] = uv; s_b[tid] = fpr; s_np[tid] = npv; }
    (void)s_li;
#pragma unroll
    for (int c = 0; c < 4; ++c) { *(LAS u32x4*)(Q + ss * LP + part * 32 + c * 8) = pre.qv[c]; *(LAS u32x4*)(KS + ss * LP + part * 32 + c * 8) = pre.kv[c]; }
    u32x4 vv[4], cv[4];
#pragma unroll
    for (int c = 0; c < 4; ++c) { vv[c] = *(const u32x4*)(prow + PV + h * 256 + part * 32 + c * 8); cv[c] = *(const u32x4*)(CS + (size_t)ss * 128 + part * 32 + c * 8); }
    const float pm = scan128_max(uv, s_lf);
    if (tid < CL) s_M[tid] = fmaxf(mprev, pm);
    const int r = lane & 15, q = lane >> 4;
    f32x4 qnacc = {0.f, 0.f, 0.f, 0.f};
#pragma unroll
    for (int ks = 0; ks < 4; ++ks) {
        const f32x4 n0 = *(const LAS f32x4*)(s_np + ks * 32 + q * 8), n1 = *(const LAS f32x4*)(s_np + ks * 32 + q * 8 + 4);
        const u32x4 nb = {pk2(n0.x, n0.y), pk2(n0.z, n0.w), pk2(n1.x, n1.y), pk2(n1.z, n1.w)};
        qnacc = __builtin_amdgcn_mfma_f32_16x16x32_bf16(*(const LAS bf16x8*)(Q + (wave * 16 + r) * LP + ks * 32 + q * 8), __builtin_bit_cast(bf16x8, nb), qnacc, 0, 0, 0);
    }
    f32x4 sacc[1][8];
#pragma unroll
    for (int n = 0; n < 8; ++n) sacc[0][n] = (f32x4){0.f, 0.f, 0.f, 0.f};
    mma_lds<1, 8, 4>(sacc, Q + wave * 16 * LP, LP, KS, LP, lane);
    __syncthreads();
    float den[4] = {0.f, 0.f, 0.f, 0.f};
    {
        float Mr[4];
#pragma unroll
        for (int i = 0; i < 4; ++i) Mr[i] = s_M[wave * 16 + q * 4 + i];
#pragma unroll
        for (int n = 0; n < 8; ++n) { const int s = n * 16 + r; const float us = s_u[s];
#pragma unroll
            for (int i = 0; i < 4; ++i) { const int j = wave * 16 + q * 4 + i; float wgt = __expf(fminf(us - Mr[i], 0.f)); wgt = (s <= j) ? wgt : 0.f; const float sp = sacc[0][n][i] * wgt; den[i] += sp;
                KS[j * LP + s] = f2bf(sp); } }
    }
#pragma unroll
    for (int i = 0; i < 4; ++i) { den[i] += __shfl_xor(den[i], 1); den[i] += __shfl_xor(den[i], 2); den[i] += __shfl_xor(den[i], 4); den[i] += __shfl_xor(den[i], 8); }
    float isc[4], Mj[4], bj[4], qn[4];
#pragma unroll
    for (int i = 0; i < 4; ++i) { const int j = wave * 16 + q * 4 + i; Mj[i] = s_M[j]; bj[i] = s_b[j]; qn[i] = qnacc[i]; isc[i] = __expf(mprev - Mj[i]); }
#pragma unroll
    for (int c = 0; c < 4; ++c) { *(LAS u32x4*)(VT + ss * LP + part * 32 + c * 8) = vv[c]; *(LAS u32x4*)(CP + ss * LP + part * 32 + c * 8) = cv[c]; }
#pragma unroll
    for (int c = 0; c < 4; ++c) { vv[c] = *(const u32x4*)(prow + PV + h * 256 + 128 + part * 32 + c * 8); cv[c] = *(const u32x4*)(CS + (size_t)(128 + ss) * 128 + part * 32 + c * 8); }
    __syncthreads();
    f32x4 acc[2][1][8];
#pragma unroll
    for (int n = 0; n < 8; ++n) acc[0][0][n] = (f32x4){0.f, 0.f, 0.f, 0.f};
    mma_lds<1, 8, 4>(acc[0], Q + wave * 16 * LP, LP, CP, LP, lane);
#pragma unroll
    for (int n = 0; n < 8; ++n)
#pragma unroll
        for (int i = 0; i < 4; ++i) acc[0][0][n][i] *= isc[i];
    mma_lds_bt<1, 8, 4>(acc[0], KS + wave * 16 * LP, LP, VT, LP, lane);
    __syncthreads();
#pragma unroll
    for (int c = 0; c < 4; ++c) { *(LAS u32x4*)(VT + ss * LP + part * 32 + c * 8) = vv[c]; *(LAS u32x4*)(CP + ss * LP + part * 32 + c * 8) = cv[c]; }
    u16* obase = P + (size_t)(t0 + (tid >> 5)) * LDP + PO + h * 256 + (tid & 31) * 8; const u16* zbase = obase + (PZM - PO);
    u32x4 zvv[8];
#pragma unroll
    for (int it = 0; it < 8; ++it) zvv[it] = *(const u32x4*)(zbase + (size_t)(16 * it) * LDP);
    __syncthreads();
#pragma unroll
    for (int n = 0; n < 8; ++n) acc[1][0][n] = (f32x4){0.f, 0.f, 0.f, 0.f};
    mma_lds<1, 8, 4>(acc[1], Q + wave * 16 * LP, LP, CP, LP, lane);
#pragma unroll
    for (int n = 0; n < 8; ++n)
#pragma unroll
        for (int i = 0; i < 4; ++i) acc[1][0][n][i] *= isc[i];
    mma_lds_bt<1, 8, 4>(acc[1], KS + wave * 16 * LP, LP, VT, LP, lane);
    const float scale = 0.08838834764831845f;
    float fac[4];
#pragma unroll
    for (int i = 0; i < 4; ++i) { const float dt = scale * (den[i] + isc[i] * qn[i]); const float dn = fmaxf(fabsf(dt), __expf(-(bj[i] + Mj[i]))); fac[i] = scale / dn; }
    __syncthreads();
#pragma unroll
    for (int hf = 0; hf < 2; ++hf)
#pragma unroll
        for (int n = 0; n < 8; ++n)
#pragma unroll
            for (int i = 0; i < 4; ++i) HB[(wave * 16 + q * 4 + i) * 260 + hf * 128 + n * 16 + r] = acc[hf][0][n][i] * fac[i];
    __syncthreads();
    m4_load(p, next_item, pre);
    {
        const int j = ss;
        float sq = 0.f;
#pragma unroll
        for (int it = 0; it < 8; ++it) { const int vd = (it * 4 + part) * 8; const f32x4 a = *(const LAS f32x4*)(HB + j * 260 + vd), b = *(const LAS f32x4*)(HB + j * 260 + vd + 4);
            sq += (a.x * a.x + a.y * a.y) + (a.z * a.z + a.w * a.w) + (b.x * b.x + b.y * b.y) + (b.z * b.z + b.w * b.w); }
        sq += __shfl_xor(sq, 1); sq += __shfl_xor(sq, 2);
        if (part == 0) s_u[j] = rsqrtf(sq * (1.f / 256.f) + EPS);
    }
    __syncthreads();
    {
        const int vd = (tid & 31) * 8;
        const f32x4 w0 = *(const LAS f32x4*)(sm + 896 + vd), w1 = *(const LAS f32x4*)(sm + 896 + vd + 4);
        const float wv[8] = {w0.x, w0.y, w0.z, w0.w, w1.x, w1.y, w1.z, w1.w};
#pragma unroll
        for (int it = 0; it < 8; ++it) { const int j = (tid >> 5) + 16 * it; const float rstd = s_u[j];
            const f32x4 a = *(const LAS f32x4*)(HB + j * 260 + vd), b = *(const LAS f32x4*)(HB + j * 260 + vd + 4);
            const float hv[8] = {a.x, a.y, a.z, a.w, b.x, b.y, b.z, b.w};
            float zf[8]; unpack8(zvv[it], zf);
            float y[8];
#pragma unroll
            for (int e = 0; e < 8; ++e) y[e] = hv[e] * rstd * wv[e] * zf[e];
            u32x4 o; o.x = pk2(y[0], y[1]); o.y = pk2(y[2], y[3]); o.z = pk2(y[4], y[5]); o.w = pk2(y[6], y[7]);
            *(u32x4*)(obase + (size_t)(16 * it) * LDP) = o; }
    }
    __syncthreads();
}

__device__ __forceinline__ void phase4_ssd(const Params& p, LAS unsigned char* lds, int item) {
    const int tid = threadIdx.x, lane = tid & 63, wave = tid >> 6;
    const int g = item & 1, bc = item >> 1, t0 = bc * CL, tl0 = (bc & (NCH - 1)) * CL;
    u16* P = (u16*)(p.ws + WS_P); const u16* XC = (const u16*)(p.ws + WS_H);
    LAS u16* CM = (LAS u16*)lds;
    LAS u16* BM = (LAS u16*)(lds + 34816);
#define SSD4_XS(b_) ((LAS u16*)(lds + 34816 + (b_) * 18432))
#define SSD4_ZS(b_) ((LAS u16*)(lds + 71680 + (b_) * 18432))
#define SSD4_HP(b_) ((LAS u16*)(lds + ((b_) ? 132640 : 108544)))
    LAS float* sm = (LAS float*)(lds + 150048);
    LAS float *s_dt = sm, *s_ac = sm + 1024, *s_rs = sm + 2048;
    const u16* HS = (const u16*)p.out + (size_t)1024 * 32768;
    u32x4 zv[2], xv[2], hv[2];
#define SSD4_LOAD(head_) do { _Pragma("unroll") for (int i = 0; i < 2; ++i) { const int ch = tid + NTHR * i, row = ch >> 3, c8 = ch & 7, pp = ch >> 4, c16 = ch & 15; \
        zv[i] = *(const u32x4*)(P + (size_t)(t0 + row) * LDP + PZS + (head_) * 64 + c8 * 8); \
        xv[i] = *(const u32x4*)(XC + (size_t)(t0 + row) * 1024 + (head_) * 64 + c8 * 8); \
        hv[i] = *(const u32x4*)(HS + ((size_t)bc * 16 + (head_)) * 8192 + pp * 128 + c16 * 8); } } while (0)
    if (tid < 8) s_rs[128 + tid] = p.d_skip[g * 8 + tid];
    { const float* sg = (const float*)(p.ws + WS_SG) + (size_t)item * 2048; const float d0 = sg[tid], d1 = sg[tid + 512], a0 = sg[1024 + tid], a1 = sg[1536 + tid];
      s_dt[tid] = d0; s_dt[tid + 512] = d1; s_ac[tid] = a0; s_ac[tid + 512] = a1; }
    __syncthreads();
    {
        const int mat = tid >> 8, t8 = tid & 255, cgp = t8 & 15, sb = (t8 >> 4) * 8, chb = 1024 + mat * 256 + g * 128 + cgp * 8;
        u32x4 rawb[11]; conv_roll_load(P, t0, tl0, sb, chb, rawb);
        ConvW cw; conv_load(p, chb, cw);
        LAS u16* dstt = mat ? CM : BM; const float m0 = (tl0 + sb - 3 >= 0) ? 1.f : 0.f;
#pragma unroll
        for (int j = 0; j < 8; ++j) { float f[8]; conv_roll_row(rawb, cw, j, m0, f);
            u32x4 o; o.x = pk2(f[0], f[1]); o.y = pk2(f[2], f[3]); o.z = pk2(f[4], f[5]); o.w = pk2(f[6], f[7]); *(LAS u32x4*)(dstt + (sb + j) * LP + cgp * 8) = o; }
    }
    SSD4_LOAD(g * 8);
    __syncthreads();
    const int r = lane & 15, q = lane >> 4;
    const int lcol = wave * 16 + r;
    f32x4 cbT[8][1];
#pragma unroll
    for (int m = 0; m < 8; ++m) cbT[m][0] = (f32x4){0.f, 0.f, 0.f, 0.f};
    mma_lds<8, 1, 4>(cbT, BM, LP, CM + wave * 16 * LP, LP, lane);
    float ssq = 0.f;
    __syncthreads();
#define SSD4_STAGE(b_) do { _Pragma("unroll") for (int i = 0; i < 2; ++i) { const int ch = tid + NTHR * i, row = ch >> 3, c8 = ch & 7, pp = ch >> 4, c16 = ch & 15; \
        *(LAS u32x4*)(SSD4_ZS(b_) + row * 72 + c8 * 8) = zv[i]; *(LAS u32x4*)(SSD4_XS(b_) + row * 72 + c8 * 8) = xv[i]; *(LAS u32x4*)(SSD4_HP(b_) + pp * LP + c16 * 8) = hv[i]; } } while (0)
    SSD4_STAGE(0); SSD4_LOAD(g * 8 + 1);
#pragma unroll 1
    for (int hh = 0; hh < 8; ++hh) {
        const int head = g * 8 + hh, cb_ = hh & 1, nb_ = cb_ ^ 1;
        LAS u16* XS = SSD4_XS(cb_); LAS u16* ZS = SSD4_ZS(cb_); LAS u16* HP = SSD4_HP(cb_);
        bf16x8 mfrag[4];
        {
            const float acl = s_ac[hh * 128 + lcol];
#pragma unroll
            for (int ks = 0; ks < 4; ++ks) {
                unsigned pk[4];
#pragma unroll
                for (int hf = 0; hf < 2; ++hf) { const int m = 2 * ks + hf, sb = 16 * m + 4 * q;
                    const f32x4 a4 = *(const LAS f32x4*)(s_ac + hh * 128 + sb), d4 = *(const LAS f32x4*)(s_dt + hh * 128 + sb);
                    float v[4];
#pragma unroll
                    for (int i = 0; i < 4; ++i) { float t = cbT[m][0][i] * __expf(fminf(acl - a4[i], 0.f)) * d4[i]; v[i] = (sb + i <= lcol) ? t : 0.f; }
                    pk[2 * hf] = pk2(v[0], v[1]); pk[2 * hf + 1] = pk2(v[2], v[3]); }
                const u32x4 u = {pk[0], pk[1], pk[2], pk[3]};
                mfrag[ks] = __builtin_bit_cast(bf16x8, u);
            }
        }
        __syncthreads();
        if (hh > 0) {
#pragma unroll
            for (int i = 0; i < 2; ++i) { const int ch = tid + NTHR * i, row = ch >> 3, c8 = ch & 7; const u32x4 yv = *(const LAS u32x4*)(SSD4_ZS(nb_) + row * 72 + c8 * 8);
                *(u32x4*)(P + (size_t)(t0 + row) * LDP + PZS + (head - 1) * 64 + c8 * 8) = yv; }
        }
        if (hh < 7) { if (nb_) SSD4_STAGE(1); else SSD4_STAGE(0); if (hh < 6) SSD4_LOAD(head + 2); }
        f32x4 ya[4][1];
#pragma unroll
        for (int mt = 0; mt < 4; ++mt) ya[mt][0] = (f32x4){0.f, 0.f, 0.f, 0.f};
        mma_lds<4, 1, 4>(ya, HP, LP, CM + wave * 16 * LP, LP, lane);
        { const float ea = __expf(s_ac[hh * 128 + lcol]);
#pragma unroll
          for (int mt = 0; mt < 4; ++mt) ya[mt][0] *= ea; }
#pragma unroll
        for (int ks = 0; ks < 4; ++ks) {
#pragma unroll
            for (int mt = 0; mt < 4; ++mt) {
                const LAS u16* p0 = XS + (32 * ks + 4 * q + (r >> 2)) * 72 + 16 * mt + (r & 3) * 4;
                const v4i16_t lo = __builtin_amdgcn_ds_read_tr16_b64_v4i16((LAS v4i16_t*)p0);
                const v4i16_t hi = __builtin_amdgcn_ds_read_tr16_b64_v4i16((LAS v4i16_t*)(p0 + 16 * 72));
                const bf16x8 af = __builtin_shufflevector(lo, hi, 0, 1, 2, 3, 4, 5, 6, 7);
                ya[mt][0] = __builtin_amdgcn_mfma_f32_16x16x32_bf16(af, mfrag[ks], ya[mt][0], 0, 0, 0);
            }
        }
        const float dsk = s_rs[128 + hh];
        {
            u32x2 xs4[4], zs4[4];
#pragma unroll
            for (int mt = 0; mt < 4; ++mt) { xs4[mt] = *(const LAS u32x2*)(XS + lcol * 72 + 16 * mt + 4 * q); zs4[mt] = *(const LAS u32x2*)(ZS + lcol * 72 + 16 * mt + 4 * q); }
#pragma unroll
            for (int mt = 0; mt < 4; ++mt) {
                const float xf[4] = {bflo(xs4[mt].x), bfhi(xs4[mt].x), bflo(xs4[mt].y), bfhi(xs4[mt].y)};
                const float zf[4] = {bflo(zs4[mt].x), bfhi(zs4[mt].x), bflo(zs4[mt].y), bfhi(zs4[mt].y)};
                float y[4];
#pragma unroll
                for (int i = 0; i < 4; ++i) { y[i] = (ya[mt][0][i] + dsk * xf[i]) * zf[i]; ssq += y[i] * y[i]; }
                u32x2 o; o.x = pk2(y[0], y[1]); o.y = pk2(y[2], y[3]);
                *(LAS u32x2*)(ZS + lcol * 72 + 16 * mt + 4 * q) = o;
            }
        }
    }
#undef SSD4_LOAD
    ssq += __shfl_xor(ssq, 16); ssq += __shfl_xor(ssq, 32);
    if (q == 0) ((float*)(p.ws + WS_RSG))[2 * (size_t)(t0 + lcol) + g] = rsqrtf(ssq * (1.f / 512.f) + EPS);
    __syncthreads();
#pragma unroll
    for (int i = 0; i < 2; ++i) { const int ch = tid + NTHR * i, row = ch >> 3, c8 = ch & 7; const u32x4 yv = *(const LAS u32x4*)(SSD4_ZS(1) + row * 72 + c8 * 8);
        *(u32x4*)(P + (size_t)(t0 + row) * LDP + PZS + (g * 8 + 7) * 64 + c8 * 8) = yv; }
    __syncthreads();
#undef SSD4_STAGE
#undef SSD4_XS
#undef SSD4_ZS
#undef SSD4_HP
}

__device__ __forceinline__ void phase6(const Params& p) {
    const int lane = threadIdx.x & 63, wave = threadIdx.x >> 6;
    const int gw = blockIdx.x * 8 + wave, NGW = gridDim.x * 8;
    const u16* Z = (const u16*)(p.ws + WS_H);
    f32x4 nw[4];
#pragma unroll
    for (int j = 0; j < 4; ++j) nw[j] = ((const f32x4*)p.fnw)[lane + 64 * j];
    for (int r4 = gw; r4 < T / 4; r4 += NGW) {
        u32x2 zv[4][4]; float s[4]; f32x4 f[4][4];
#pragma unroll
        for (int k = 0; k < 4; ++k)
#pragma unroll
            for (int j = 0; j < 4; ++j) { zv[k][j] = ((const u32x2*)(Z + (size_t)(4 * r4 + k) * DM))[lane + 64 * j]; f[k][j] = __builtin_nontemporal_load((const f32x4*)(p.x + (size_t)(4 * r4 + k) * DM) + lane + 64 * j); }
#pragma unroll
        for (int k = 0; k < 4; ++k) { s[k] = 0.f;
#pragma unroll
            for (int j = 0; j < 4; ++j) { f[k][j] += (f32x4){bflo(zv[k][j].x), bfhi(zv[k][j].x), bflo(zv[k][j].y), bfhi(zv[k][j].y)};
                s[k] += (f[k][j].x * f[k][j].x + f[k][j].y * f[k][j].y) + (f[k][j].z * f[k][j].z + f[k][j].w * f[k][j].w); } }
#pragma unroll
        for (int o = 1; o < 64; o <<= 1) {
#pragma unroll
            for (int k = 0; k < 4; ++k) s[k] += __shfl_xor(s[k], o); }
#pragma unroll
        for (int k = 0; k < 4; ++k) { const float rstd = rsqrtf(s[k] * (1.f / DM) + EPS);
#pragma unroll
            for (int j = 0; j < 4; ++j) ((f32x4*)(p.out + (size_t)(4 * r4 + k) * DM))[lane + 64 * j] = f[k][j] * rstd * nw[j]; }
    }
}

__global__ void __launch_bounds__(NTHR) fwd_kernel(Params p) {
    extern __shared__ __attribute__((aligned(16))) unsigned char lds_raw[];
    LAS unsigned char* lds = (LAS unsigned char*)lds_raw;
    cg::grid_group grid = cg::this_grid();
    const int lo = p.ph_lo, hi = p.ph_hi;
    if (lo < 0) grid.sync();
    volatile LAS unsigned* xbst = (volatile LAS unsigned*)(lds + LDS_BYTES - 16);
    if (threadIdx.x < 4) xbst[threadIdx.x] = 0u;
    __syncthreads();
    XcdBarrier bar = xcd_barrier_post((unsigned*)(p.ws + WS_BAR), xbst);
#ifndef PHMASK
#define PHMASK 127
#endif
#define IN(k) (((PHMASK >> (k)) & 1) && lo <= (k) && (k) < hi)
#define SEAM(k) do { if (IN(k) && IN((k) + 1)) xcd_barrier(bar); } while (0)
#ifndef PROBE
#define PROBE 0
#endif
#define GSYNC() do { if (hi - lo > 1) xcd_barrier(bar); } while (0)
#define PH1() do { pg8::Gemm g{(const u16*)(p.ws + WS_H), (const u16*)(p.ws + WS_WTIN), T, LDP, DM, DM}; pg8::StaticOrder S; S.init(T, LDP, gridDim.x, blockIdx.x); \
        pg8::EpiP E{(u16*)(p.ws + WS_P), LDP, nullptr}; pg8::gemm_phase<pg8::EpiP, pg8::StaticOrder>(lds, g, S, E); } while (0)
#define PH2() do { for (int it = blockIdx.x; it < 512; it += gridDim.x) phase2_ssd(p, lds, it);     \
        { M2Pre pre_; if ((int)blockIdx.x < 1024) m2_load(p, blockIdx.x, pre_); for (int it = blockIdx.x; it < 1024; it += gridDim.x) { const int nx_ = it + gridDim.x; phase2_mlstm(p, lds, it, pre_, nx_ < 1024 ? nx_ : it); } } } while (0)
#define PH4() do { { M4Pre pre_; if ((int)blockIdx.x < 1024) m4_load(p, blockIdx.x, pre_); for (int it = blockIdx.x; it < 1024; it += gridDim.x) { const int nx_ = it + gridDim.x; phase4_mlstm(p, lds, it, pre_, nx_ < 1024 ? nx_ : it, it == (int)blockIdx.x || (gridDim.x & 3) != 0); } } \
        for (int it = blockIdx.x; it < 512; it += gridDim.x) phase4_ssd(p, lds, it); } while (0)
#define PH5() do { pg8::Gemm g{(const u16*)(p.ws + WS_P) + PO, (const u16*)(p.ws + WS_WTOUT), T, DM, 2048, LDP}; pg8::StaticOrder S; S.init(T, DM, gridDim.x, blockIdx.x); \
        pg8::EpiOut E{(u16*)(p.ws + WS_H), p.x, DM, (const float*)(p.ws + WS_RSG)}; pg8::gemm_phase<pg8::EpiOut, pg8::StaticOrder>(lds, g, S, E); } while (0)
    if (IN(0)) { phase0(p, lds); if (PROBE == 1) { GSYNC(); phase0(p, lds); } }
    SEAM(0);
    if (IN(1)) { PH1(); if (PROBE == 2) { GSYNC(); PH1(); } }
    SEAM(1);
    if (IN(2)) { PH2(); if (PROBE == 3) { GSYNC(); PH2(); } }
    SEAM(2);
    if (IN(3)) { phase3(p); if (PROBE == 4) { GSYNC(); PH2(); GSYNC(); phase3(p); } }
    SEAM(3);
    if (IN(4)) PH4();
    SEAM(4);
    if (IN(5)) { PH5(); if (PROBE == 6) { GSYNC(); PH5(); } }
    SEAM(5);
    if (IN(6)) { phase6(p); if (PROBE == 5) { GSYNC(); PH5(); GSYNC(); phase6(p); } }
#undef IN
#undef SEAM
}

extern "C" void kernel_launch(void* const* d_in, const int* in_sizes, int n_in, void* d_out, int out_size, void* d_ws, size_t ws_size, hipStream_t stream) {
    static int grid = 0;
    if (grid == 0) {
        if (n_in != 14 || out_size != T * DM || ws_size < WS_END) { fprintf(stderr, "kernel_launch: unexpected sizes n_in %d out %d ws %zu (need %zu)\n", n_in, out_size, ws_size, (size_t)WS_END); grid = -1; return; }
        int dev = 0, cus = 0;
        hipGetDevice(&dev); hipDeviceGetAttribute(&cus, hipDeviceAttributeMultiprocessorCount, dev);
        if (hipFuncSetAttribute((const void*)fwd_kernel, hipFuncAttributeMaxDynamicSharedMemorySize, LDS_BYTES) != hipSuccess) { fprintf(stderr, "kernel_launch: hipFuncSetAttribute failed\n"); grid = -1; return; }
        int per_cu = 0;
        if (hipOccupancyMaxActiveBlocksPerMultiprocessor(&per_cu, (const void*)fwd_kernel, NTHR, LDS_BYTES) != hipSuccess || per_cu < 1) { fprintf(stderr, "kernel_launch: occupancy query says %d\n", per_cu); }
        (void)hipGetLastError();
        grid = cus > 0 ? cus : 256;
    }
    if (grid < 0) return;
    Params p{};
    p.x = (const float*)d_in[0]; p.norm_w = (const float*)d_in[1]; p.w_in = (const float*)d_in[2]; p.b_i = (const float*)d_in[3]; p.b_f = (const float*)d_in[4];
    p.conv_w = (const float*)d_in[5]; p.conv_b = (const float*)d_in[6]; p.dt_bias = (const float*)d_in[7]; p.a_log = (const float*)d_in[8]; p.d_skip = (const float*)d_in[9];
    p.mnw = (const float*)d_in[10]; p.snw = (const float*)d_in[11]; p.w_out = (const float*)d_in[12]; p.fnw = (const float*)d_in[13];
    p.out = (float*)d_out; p.ws = (unsigned char*)d_ws;
    (void)hipMemsetAsync((char*)d_ws + WS_BAR, 0, 16384, stream);
#if ONE_LAUNCH
    p.ph_lo = 0; p.ph_hi = 7;
    void* args[] = {&p};
    hipError_t e = hipLaunchCooperativeKernel((const void*)fwd_kernel, dim3(grid), dim3(NTHR), args, LDS_BYTES, stream);
    if (e != hipSuccess) fprintf(stderr, "cooperative launch failed: %s (grid %d)\n", hipGetErrorString(e), grid);
#else
    for (int ph = 0; ph < 7; ++ph) { p.ph_lo = ph; p.ph_hi = ph + 1; hipLaunchKernelGGL(fwd_kernel, dim3(grid), dim3(NTHR), LDS_BYTES, stream, p); }
#endif
}
```
